# Optimizing an MI355X kernel written in HIP

```python
import math
import jax, jax.numpy as jnp
from jax import lax
import numpy as np

D_MODEL = 1024
BATCH = 32
SEQ = 256
DEPTH = 4
DEC_BATCH = 8
DEC_SEQ = 4096
PAST_LEN = 512

GRID_W = 64
N_MIXERS = 4
QB = 128
ROPE_BASE = 10000.0
LN_EPS = 1e-5
NEG_INF = -1e30
ALPHA = (2 * DEPTH) ** 0.25
BETA = (8 * DEPTH) ** -0.25
D_FF = 4 * D_MODEL
DIFF_DH = 64
DIFF_HEADS = D_MODEL // (2 * DIFF_DH)
DIFF_LAMBDA_INIT = 0.8 - 0.6 * math.exp(-0.3 * 0)
NA_DH = 64
NA_HEADS = D_MODEL // NA_DH
NA_KH = 8
NA_KW = 16
MLA_HEADS = 16
MLA_NOPE = 64
MLA_ROPE = 32
MLA_VDIM = 64
MLA_Q_RANK = D_MODEL // 2
MLA_KV_RANK = D_MODEL // 4
SWA_DH = 64
SWA_HEADS = D_MODEL // SWA_DH
SWA_KV_HEADS = 4
SWA_WINDOW = 128

kernel_name = 'hybrid_diffusion_interleaved_step'


def layer_norm(x, g, b):
    xf = x.astype(jnp.float32)
    mu = jnp.mean(xf, -1, keepdims=True)
    var = jnp.mean(jnp.square(xf - mu), -1, keepdims=True)
    return ((xf - mu) * lax.rsqrt(var + LN_EPS) * g + b).astype(x.dtype)


def rms_norm(x, g):
    xf = x.astype(jnp.float32)
    return (xf * lax.rsqrt(jnp.mean(xf * xf, -1, keepdims=True) + LN_EPS) * g).astype(x.dtype)


def axial_rope(x):
    T, R = x.shape[1], x.shape[-1]
    n = R // 4
    t = jnp.arange(T)
    inv = ROPE_BASE ** (-jnp.arange(n, dtype=jnp.float32) / n)
    bshape = (T,) + (1,) * (x.ndim - 3) + (n,)

    def rot(xh, pos):
        ang = (pos.astype(jnp.float32)[:, None] * inv).reshape(bshape)
        cos, sin = jnp.cos(ang).astype(x.dtype), jnp.sin(ang).astype(x.dtype)
        x1, x2 = xh[..., :n], xh[..., n:]
        return jnp.concatenate([x1 * cos - x2 * sin, x2 * cos + x1 * sin], -1)

    half = R // 2
    return jnp.concatenate([rot(x[..., :half], t // GRID_W), rot(x[..., half:], t % GRID_W)], -1)


def map_query_blocks(fn, *qs):
    B, T = qs[0].shape[:2]
    nb = T // QB
    blocks = tuple(jnp.moveaxis(a.reshape((B, nb, QB) + a.shape[2:]), 1, 0) for a in qs)
    out = lax.map(lambda args: fn(*args), blocks)
    return jnp.moveaxis(out, 0, 1).reshape((B, T) + out.shape[3:])


def dense_attend(q, k, v, sink=None):
    B, T, Hq, dh = q.shape
    Hk = k.shape[2]
    G = Hq // Hk
    scale = dh ** -0.5

    def block(qb):
        qg = qb.reshape(B, QB, Hk, G, dh)
        logits = jnp.einsum('bqkgd,bskd->bkgqs', qg, k, preferred_element_type=jnp.float32) * scale
        if sink is not None:
            s = jnp.broadcast_to(sink.astype(jnp.float32).reshape(1, Hk, G, 1, 1), logits.shape[:-1] + (1,))
            p = jax.nn.softmax(jnp.concatenate([logits, s], -1), -1)[..., :-1]
        else:
            p = jax.nn.softmax(logits, -1)
        o = jnp.einsum('bkgqs,bskd->bqkgd', p, v)
        return o.reshape(B, QB, Hq, dh).astype(v.dtype)

    return map_query_blocks(block, q)


def modulation(cond, w, b):
    m = jax.nn.silu(cond) @ w + b
    return m.reshape(m.shape[:-1] + (6, D_MODEL))


def modulate(x, shift, scale):
    return x * (1 + scale) + shift


def sq_relu_mlp(h, w1, w2):
    return jnp.square(jax.nn.relu(h @ w1)) @ w2


def diff_qkv(h, w_qkv):
    B, T, _ = h.shape
    q, k, v = jnp.split(h @ w_qkv, 3, -1)
    q = q.reshape(B, T, DIFF_HEADS, 2, DIFF_DH)
    k = k.reshape(B, T, DIFF_HEADS, 2, DIFF_DH)
    v = v.reshape(B, T, DIFF_HEADS, 2 * DIFF_DH)
    return q, k, v


def diff_lambda(lam):
    lf = lam.astype(jnp.float32)
    return jnp.exp(jnp.sum(lf[0] * lf[1])) - jnp.exp(jnp.sum(lf[2] * lf[3])) + DIFF_LAMBDA_INIT


def diff_attend(q, k, v, lam, subln):
    B, T = q.shape[:2]
    scale = DIFF_DH ** -0.5

    def block(qb):
        logits = jnp.einsum('bqhmd,bkhmd->bhmqk', qb, k, preferred_element_type=jnp.float32) * scale
        p = jax.nn.softmax(logits, -1)
        a = p[:, :, 0] - lam * p[:, :, 1]
        return jnp.einsum('bhqk,bkhe->bqhe', a, v).astype(v.dtype)

    o = map_query_blocks(block, q)
    o = rms_norm(o, subln) * (1.0 - DIFF_LAMBDA_INIT)
    return o.reshape(B, T, D_MODEL)


def diff_ctx(h, w_qkv, lam, subln, w_o):
    B, S, _ = h.shape
    q, k, v = diff_qkv(h, w_qkv)
    o = diff_attend(q, k, v, diff_lambda(lam), subln)
    return o @ w_o, (k.reshape(B, S, DIFF_HEADS, 2 * DIFF_DH), v)


def diff_lat(h, ck, cv, w_qkv, lam, subln, w_o):
    B, P = ck.shape[:2]
    q, k, v = diff_qkv(h, w_qkv)
    q, k = axial_rope(q), axial_rope(k)
    k_all = jnp.concatenate([ck.reshape(B, P, DIFF_HEADS, 2, DIFF_DH), k], 1)
    v_all = jnp.concatenate([cv, v], 1)
    return diff_attend(q, k_all, v_all, diff_lambda(lam), subln) @ w_o


def na_qkv(h, w_qkv):
    B, T, _ = h.shape
    q, k, v = jnp.split(h @ w_qkv, 3, -1)
    shp = (B, T, NA_HEADS, NA_DH)
    return q.reshape(shp), k.reshape(shp), v.reshape(shp)


def na_ctx(h, w_qkv, rpb, w_o):
    B, S, _ = h.shape
    q, k, v = na_qkv(h, w_qkv)
    o = dense_attend(q, k, v)
    return o.reshape(B, S, D_MODEL) @ w_o, (k, v)


def na_lat(h, ck, cv, w_qkv, rpb, w_o):
    B, T, _ = h.shape
    rows = T // GRID_W
    kh = min(NA_KH, rows)
    q, k, v = na_qkv(h, w_qkv)
    grid = lambda a: a.reshape(B, rows, GRID_W, NA_HEADS, NA_DH)
    qg, kg, vg = grid(q), grid(k), grid(v)
    cols = np.arange(GRID_W)
    c0 = np.clip(cols - NA_KW // 2, 0, GRID_W - NA_KW)
    col_idx = c0[:, None] + np.arange(NA_KW)
    col_rel = col_idx - cols[:, None] + NA_KW - 1
    n_nb = kh * NA_KW
    scale = NA_DH ** -0.5

    def row_block(args):
        r, qr = args
        r0 = jnp.clip(r - kh // 2, 0, rows - kh)
        ks = lax.dynamic_slice_in_dim(kg, r0, kh, axis=1)[:, :, col_idx]
        vs = lax.dynamic_slice_in_dim(vg, r0, kh, axis=1)[:, :, col_idx]
        row_rel = r0 - r + jnp.arange(kh) + NA_KH - 1
        bias = rpb[:, row_rel][:, :, col_rel]
        ln = jnp.einsum('bchd,bicjhd->bhcij', qr, ks, preferred_element_type=jnp.float32) * scale
        ln = ln + jnp.transpose(bias, (0, 2, 1, 3)).astype(jnp.float32)[None]
        lc = jnp.einsum('bchd,bshd->bhcs', qr, ck, preferred_element_type=jnp.float32) * scale
        p = jax.nn.softmax(jnp.concatenate([ln.reshape(B, NA_HEADS, GRID_W, n_nb), lc], -1), -1)
        pn = p[..., :n_nb].reshape(B, NA_HEADS, GRID_W, kh, NA_KW)
        o = jnp.einsum('bhcij,bicjhd->bchd', pn, vs) + jnp.einsum('bhcs,bshd->bchd', p[..., n_nb:], cv)
        return o.astype(h.dtype)

    o = lax.map(row_block, (jnp.arange(rows), jnp.moveaxis(qg, 1, 0)))
    return jnp.moveaxis(o, 0, 1).reshape(B, T, D_MODEL) @ w_o


def mla_project(h, w_a, q_norm, kv_norm, w_uq):
    B, T, _ = h.shape
    a = h @ w_a
    cq = a[..., :MLA_Q_RANK]
    ckv = a[..., MLA_Q_RANK:MLA_Q_RANK + MLA_KV_RANK]
    kpe = a[..., MLA_Q_RANK + MLA_KV_RANK:]
    q = (rms_norm(cq, q_norm) @ w_uq).reshape(B, T, MLA_HEADS, MLA_NOPE + MLA_ROPE)
    return q[..., :MLA_NOPE], q[..., MLA_NOPE:], rms_norm(ckv, kv_norm), kpe


def mla_expand(ckv, w_ukv):
    B, T, _ = ckv.shape
    kv = (ckv @ w_ukv).reshape(B, T, MLA_HEADS, MLA_NOPE + MLA_VDIM)
    return kv[..., :MLA_NOPE], kv[..., MLA_NOPE:]


def mla_attend(qn, qp, kn, kp, v):
    scale = (MLA_NOPE + MLA_ROPE) ** -0.5

    def block(qnb, qpb):
        logits = (jnp.einsum('bqhd,bkhd->bhqk', qnb, kn, preferred_element_type=jnp.float32)
                  + jnp.einsum('bqhr,bkr->bhqk', qpb, kp, preferred_element_type=jnp.float32)) * scale
        p = jax.nn.softmax(logits, -1)
        return jnp.einsum('bhqk,bkhd->bqhd', p, v).astype(v.dtype)

    return map_query_blocks(block, qn, qp)


def mla_ctx(h, w_a, q_norm, kv_norm, w_uq, w_ukv, w_o):
    B, S, _ = h.shape
    qn, qp, ckv, kpe = mla_project(h, w_a, q_norm, kv_norm, w_uq)
    kn, v = mla_expand(ckv, w_ukv)
    o = mla_attend(qn, qp, kn, kpe, v)
    return o.reshape(B, S, MLA_HEADS * MLA_VDIM) @ w_o, (ckv, kpe)


def mla_lat(h, c_ckv, c_kpe, w_a, q_norm, kv_norm, w_uq, w_ukv, w_o):
    B, T, _ = h.shape
    qn, qp, ckv, kpe = mla_project(h, w_a, q_norm, kv_norm, w_uq)
    qp = axial_rope(qp)
    kpe = axial_rope(kpe[:, :, None, :])[:, :, 0]
    kn, v = mla_expand(jnp.concatenate([c_ckv, ckv], 1), w_ukv)
    o = mla_attend(qn, qp, kn, jnp.concatenate([c_kpe, kpe], 1), v)
    return o.reshape(B, T, MLA_HEADS * MLA_VDIM) @ w_o


def swa_qkv(h, w_qkv):
    B, T, _ = h.shape
    a = h @ w_qkv
    nq, nk = SWA_HEADS * SWA_DH, SWA_KV_HEADS * SWA_DH
    q = a[..., :nq].reshape(B, T, SWA_HEADS, SWA_DH)
    k = a[..., nq:nq + nk].reshape(B, T, SWA_KV_HEADS, SWA_DH)
    v = a[..., nq + nk:].reshape(B, T, SWA_KV_HEADS, SWA_DH)
    return q, k, v


def swa_ctx(h, w_qkv, sink, w_o):
    B, S, _ = h.shape
    q, k, v = swa_qkv(h, w_qkv)
    o = dense_attend(q, k, v, sink)
    return o.reshape(B, S, SWA_HEADS * SWA_DH) @ w_o, (k, v)


def swa_lat(h, ck, cv, w_qkv, sink, w_o):
    B, T, _ = h.shape
    P = ck.shape[1]
    nb = T // QB
    G = SWA_HEADS // SWA_KV_HEADS
    scale = SWA_DH ** -0.5
    q, k, v = swa_qkv(h, w_qkv)
    q, k = axial_rope(q), axial_rope(k)

    def band(a):
        ab = a.reshape((B, nb, QB) + a.shape[2:])
        ap = jnp.pad(ab, [(0, 0), (1, 1)] + [(0, 0)] * (ab.ndim - 2))
        return jnp.moveaxis(jnp.concatenate([ap[:, :-2], ap[:, 1:-1], ap[:, 2:]], axis=2), 1, 0)

    qi = np.arange(QB)[:, None]
    kj = np.arange(3 * QB)[None, :]
    kpos = (np.arange(nb)[:, None, None] - 1) * QB + kj[None]
    mask = (np.abs(kj - QB - qi) <= SWA_WINDOW)[None] & (kpos >= 0) & (kpos < T)
    sink_l = sink.astype(jnp.float32).reshape(1, SWA_KV_HEADS, G, 1, 1)

    def block(args):
        qb, kb, vb, mb = args
        qg = qb.reshape(B, QB, SWA_KV_HEADS, G, SWA_DH)
        lw = jnp.einsum('bqkgd,bskd->bkgqs', qg, kb, preferred_element_type=jnp.float32) * scale
        lw = jnp.where(mb, lw, NEG_INF)
        lc = jnp.einsum('bqkgd,bskd->bkgqs', qg, ck, preferred_element_type=jnp.float32) * scale
        ls = jnp.broadcast_to(sink_l, lw.shape[:-1] + (1,))
        p = jax.nn.softmax(jnp.concatenate([lw, lc, ls], -1), -1)
        o = (jnp.einsum('bkgqs,bskd->bqkgd', p[..., :3 * QB], vb)
             + jnp.einsum('bkgqs,bskd->bqkgd', p[..., 3 * QB:3 * QB + P], cv))
        return o.reshape(B, QB, SWA_HEADS, SWA_DH).astype(h.dtype)

    qb = jnp.moveaxis(q.reshape(B, nb, QB, SWA_HEADS, SWA_DH), 1, 0)
    o = lax.map(block, (qb, band(k), band(v), jnp.asarray(mask)))
    return jnp.moveaxis(o, 0, 1).reshape(B, T, SWA_HEADS * SWA_DH) @ w_o


def setup_inputs(seed: int = 0) -> dict:
    key = jax.random.key(seed)
    ks = iter(jax.random.split(key, 48))

    def nrm(shape, scale=1.0):
        return jax.random.normal(next(ks), shape, jnp.float32) * scale

    D = D_MODEL
    inv = D ** -0.5
    return {
        'x_prompt': nrm((BATCH, SEQ, D)),
        'x_sample': nrm((DEC_BATCH, DEC_SEQ, D)),
        'cache_l0_k': nrm((DEC_BATCH, PAST_LEN, DIFF_HEADS, 2 * DIFF_DH)),
        'cache_l0_v': nrm((DEC_BATCH, PAST_LEN, DIFF_HEADS, 2 * DIFF_DH)),
        'cache_l1_k': nrm((DEC_BATCH, PAST_LEN, NA_HEADS, NA_DH)),
        'cache_l1_v': nrm((DEC_BATCH, PAST_LEN, NA_HEADS, NA_DH)),
        'cache_l2_ckv': nrm((DEC_BATCH, PAST_LEN, MLA_KV_RANK)),
        'cache_l2_kpe': nrm((DEC_BATCH, PAST_LEN, MLA_ROPE)),
        'cache_l3_k': nrm((DEC_BATCH, PAST_LEN, SWA_KV_HEADS, SWA_DH)),
        'cache_l3_v': nrm((DEC_BATCH, PAST_LEN, SWA_KV_HEADS, SWA_DH)),
        'c': nrm((DEC_BATCH, D)),
        'c_ctx': nrm((D,)),
        'w_mod': nrm((DEPTH, D, 6 * D), inv),
        'b_mod': nrm((DEPTH, 6 * D), 0.02),
        'ln_g': 1.0 + nrm((DEPTH, 2, D), 0.02),
        'ln_b': nrm((DEPTH, 2, D), 0.02),
        'w_mlp1': nrm((DEPTH, D, D_FF), inv),
        'w_mlp2': nrm((DEPTH, D_FF, D), BETA * D_FF ** -0.5),
        'l0_w_qkv': nrm((D, 3 * D), inv),
        'l0_lam': nrm((4, DIFF_DH), 0.1),
        'l0_subln': 1.0 + nrm((2 * DIFF_DH,), 0.02),
        'l0_w_o': nrm((D, D), BETA * inv),
        'l1_w_qkv': nrm((D, 3 * D), inv),
        'l1_rpb': nrm((NA_HEADS, 2 * NA_KH - 1, 2 * NA_KW - 1), 0.1),
        'l1_w_o': nrm((D, D), BETA * inv),
        'l2_w_a': nrm((D, MLA_Q_RANK + MLA_KV_RANK + MLA_ROPE), inv),
        'l2_q_norm': 1.0 + nrm((MLA_Q_RANK,), 0.02),
        'l2_kv_norm': 1.0 + nrm((MLA_KV_RANK,), 0.02),
        'l2_w_uq': nrm((MLA_Q_RANK, MLA_HEADS * (MLA_NOPE + MLA_ROPE)), MLA_Q_RANK ** -0.5),
        'l2_w_ukv': nrm((MLA_KV_RANK, MLA_HEADS * (MLA_NOPE + MLA_VDIM)), MLA_KV_RANK ** -0.5),
        'l2_w_o': nrm((MLA_HEADS * MLA_VDIM, D), BETA * (MLA_HEADS * MLA_VDIM) ** -0.5),
        'l3_w_qkv': nrm((D, (SWA_HEADS + 2 * SWA_KV_HEADS) * SWA_DH), inv),
        'l3_sink': nrm((SWA_HEADS,), 0.5),
        'l3_w_o': nrm((SWA_HEADS * SWA_DH, D), BETA * (SWA_HEADS * SWA_DH) ** -0.5),
    }


def reference(x_prompt, x_sample, cache_l0_k, cache_l0_v, cache_l1_k, cache_l1_v, cache_l2_ckv,
              cache_l2_kpe, cache_l3_k, cache_l3_v, c, c_ctx, w_mod, b_mod, ln_g, ln_b, w_mlp1, w_mlp2,
              l0_w_qkv, l0_lam, l0_subln, l0_w_o, l1_w_qkv, l1_rpb, l1_w_o, l2_w_a, l2_q_norm,
              l2_kv_norm, l2_w_uq, l2_w_ukv, l2_w_o, l3_w_qkv, l3_sink, l3_w_o):
    ctx_mixers = (diff_ctx, na_ctx, mla_ctx, swa_ctx)
    lat_mixers = (diff_lat, na_lat, mla_lat, swa_lat)
    params = ((l0_w_qkv, l0_lam, l0_subln, l0_w_o),
              (l1_w_qkv, l1_rpb, l1_w_o),
              (l2_w_a, l2_q_norm, l2_kv_norm, l2_w_uq, l2_w_ukv, l2_w_o),
              (l3_w_qkv, l3_sink, l3_w_o))
    caches = ((cache_l0_k, cache_l0_v), (cache_l1_k, cache_l1_v),
              (cache_l2_ckv, cache_l2_kpe), (cache_l3_k, cache_l3_v))
    new_state = []
    xp, xs = x_prompt, x_sample
    for i in range(DEPTH):
        m = i % N_MIXERS
        mp = modulation(c_ctx, w_mod[i], b_mod[i])
        ms = modulation(c, w_mod[i], b_mod[i])[:, :, None, :]
        y, state = ctx_mixers[m](modulate(xp, mp[0], mp[1]), *params[i])
        xp = layer_norm(ALPHA * xp + mp[2] * y, ln_g[i, 0], ln_b[i, 0])
        y = sq_relu_mlp(modulate(xp, mp[3], mp[4]), w_mlp1[i], w_mlp2[i])
        xp = layer_norm(ALPHA * xp + mp[5] * y, ln_g[i, 1], ln_b[i, 1])
        new_state.extend(state)
        y = lat_mixers[m](modulate(xs, ms[:, 0], ms[:, 1]), *caches[i], *params[i])
        xs = layer_norm(ALPHA * xs + ms[:, 2] * y, ln_g[i, 0], ln_b[i, 0])
        y = sq_relu_mlp(modulate(xs, ms[:, 3], ms[:, 4]), w_mlp1[i], w_mlp2[i])
        xs = layer_norm(ALPHA * xs + ms[:, 5] * y, ln_g[i, 1], ln_b[i, 1])
    return (xp, xs, *new_state)
```

```cpp
#include <hip/hip_runtime.h>
#include <hip/hip_cooperative_groups.h>
#include <cstdio>
namespace cg = cooperative_groups;

typedef unsigned short u16;
typedef unsigned int u32;
using bf16x8 = __attribute__((ext_vector_type(8))) short;
using f32x16 = __attribute__((ext_vector_type(16))) float;
typedef __bf16 bf2_t __attribute__((ext_vector_type(2)));
typedef float f2_t __attribute__((ext_vector_type(2)));
typedef float f4_t __attribute__((ext_vector_type(4)));
#define DI __device__ __forceinline__
#define MFMA(a, b, c) __builtin_amdgcn_mfma_f32_32x32x16_bf16((a), (b), (c), 0, 0, 0)

DI u32 pk2(float a, float b) { f2_t v = {a, b}; bf2_t r = __builtin_convertvector(v, bf2_t); return __builtin_bit_cast(u32, r); }
DI float bf2f(u16 x) { return __uint_as_float(((u32)x) << 16); }
DI float ex2(float x) { return __builtin_amdgcn_exp2f(x); }
typedef unsigned u2nt_t __attribute__((ext_vector_type(2)));
DI uint2 nt_load2(const u16* p) { const u2nt_t v = __builtin_nontemporal_load((const u2nt_t*)p); return make_uint2(v.x, v.y); }
DI void nt_store2(u16* p, uint2 v) { u2nt_t w = {v.x, v.y}; __builtin_nontemporal_store(w, (u2nt_t*)p); }
DI float4 nt_load4(const float* p) { const f4_t v = __builtin_nontemporal_load((const f4_t*)p); return make_float4(v.x, v.y, v.z, v.w); }
DI void nt_store4(float* p, float4 v) { f4_t w = {v.x, v.y, v.z, v.w}; __builtin_nontemporal_store(w, (f4_t*)p); }
DI int ltid() { int t = threadIdx.x; asm volatile("" : "+v"(t)); return t; }

constexpr int NCTX = 8192, NLAT = 32768, NTOK = 40960, NKROW = 45056, DM = 1024, LATS = 4608;
constexpr size_t MiB = 1u << 20;
constexpr size_t Mi = 1u << 20;
constexpr size_t WS_R = 0, WS_H = 320 * MiB, WS_W = 400 * MiB, WS_MODS = 492 * MiB, WS_ROPE = 493 * MiB, WS_BAR = 493 * MiB + 65536, WS_TOTAL = 494 * MiB;
constexpr size_t R_Q = 0, R_K = 120 * MiB, R_VT = 208 * MiB, R_KPE = 296 * MiB;
constexpr size_t W_MLP1 = 0, W_MLP2 = 16 * Mi;
constexpr size_t W_L0QKV = 32 * Mi, W_L0O = 35 * Mi, W_L1QKV = 36 * Mi, W_L1O = 39 * Mi;
constexpr size_t W_L2A = 40 * Mi;
constexpr size_t W_L2UQ = W_L2A + 1024 * 1024;
constexpr size_t W_L2UKV = W_L2UQ + 1536 * 512;
constexpr size_t W_L2O = W_L2UKV + 2048 * 256;
constexpr size_t W_L3QKV = W_L2O + Mi;
constexpr size_t W_L3O = W_L3QKV + 1536 * 1024;
constexpr size_t O_K0 = 41943040, O_V0 = 50331648, O_K1 = 58720256, O_V1 = 67108864, O_CKV2 = 75497472,
                 O_KPE2 = 77594624, O_K3 = 77856768, O_V3 = 79953920;
constexpr float LOG2E = 1.4426950408889634f;
constexpr float ALPHA = 1.681792830507429f;

struct Params {
  const float* in[34];
  float* out;
  char* ws;
};

constexpr int TLD = 72;
DI void transpose_weight(const float* __restrict__ W, u16* __restrict__ Wt, int K, int N, int Npad, int perm, char* smem) {
  u16* sm = (u16*)smem;
  const int tid = ltid();
  const int nkt = K >> 6, nnt = Npad >> 6;
  for (int tile = blockIdx.x; tile < nkt * nnt; tile += gridDim.x) {
    const int kt = tile % nkt, nt = tile / nkt;
    const int k0 = kt << 6, n0 = nt << 6;
#pragma unroll
    for (int i = 0; i < 2; ++i) {
      const int idx = tid + 512 * i;
      const int kr = idx >> 4, c4 = idx & 15;
      float4 v = make_float4(0.f, 0.f, 0.f, 0.f);
      if (n0 + c4 * 4 < N) v = nt_load4(W + (size_t)(k0 + kr) * N + n0 + c4 * 4);
      const u32 a = pk2(v.x, v.y), b = pk2(v.z, v.w);
      sm[(c4 * 4 + 0) * TLD + kr] = (u16)(a & 0xffff);
      sm[(c4 * 4 + 1) * TLD + kr] = (u16)(a >> 16);
      sm[(c4 * 4 + 2) * TLD + kr] = (u16)(b & 0xffff);
      sm[(c4 * 4 + 3) * TLD + kr] = (u16)(b >> 16);
    }
    __syncthreads();
    {
      const int idx = tid;
      const int nl = idx >> 3, kc = idx & 7;
      int nn = n0 + nl;
      if (perm) nn = ((nn & 127) < 64) ? ((nn >> 7) * 64 + (nn & 63)) : (1024 + (nn >> 7) * 64 + ((nn & 127) - 64));
      *(uint4*)(Wt + (size_t)nn * K + k0 + kc * 8) = *(const uint4*)(sm + nl * TLD + kc * 8);
    }
    __syncthreads();
  }
}

DI void mods_item(const Params& p, int item, char* smem) {
  float* ssilu = (float*)smem;
  float* sred = ssilu + 9216;
  const int tid = ltid();
  const int l = item / 96, n0 = (item % 96) * 64;
  const float* cctx = p.in[11];
  const float* cv = p.in[10];
  for (int i = tid; i < 9216; i += 512) {
    const int r = i >> 10, k = i & 1023;
    const float c = (r == 0) ? cctx[k] : cv[(r - 1) * 1024 + k];
    ssilu[i] = c / (1.f + expf(-c));
  }
  __syncthreads();
  const int kg = tid >> 4, cl = tid & 15;
  float acc[9][4];
#pragma unroll
  for (int r = 0; r < 9; ++r) { acc[r][0] = 0.f; acc[r][1] = 0.f; acc[r][2] = 0.f; acc[r][3] = 0.f; }
  const float* W = p.in[12] + (size_t)l * 1024 * 6144 + n0 + cl * 4;
  for (int kk = 0; kk < 32; ++kk) {
    const int k = kg * 32 + kk;
    const float4 w4 = nt_load4(W + (size_t)k * 6144);
#pragma unroll
    for (int r = 0; r < 9; ++r) {
      const float s = ssilu[r * 1024 + k];
      acc[r][0] += s * w4.x; acc[r][1] += s * w4.y; acc[r][2] += s * w4.z; acc[r][3] += s * w4.w;
    }
  }
#pragma unroll
  for (int r = 0; r < 9; ++r)
    *(float4*)(sred + (kg * 9 + r) * 64 + cl * 4) = make_float4(acc[r][0], acc[r][1], acc[r][2], acc[r][3]);
  __syncthreads();
  float* mods = (float*)(p.ws + WS_MODS);
  for (int o = tid; o < 576; o += 512) {
    const int r = o >> 6, nn = o & 63;
    float s = p.in[13][l * 6144 + n0 + nn];
#pragma unroll
    for (int g = 0; g < 32; ++g) s += sred[(g * 9 + r) * 64 + nn];
    mods[(size_t)(l * 9 + r) * 6144 + n0 + nn] = s;
  }
  __syncthreads();
}

DI void prepass(const Params& p, char* smem) {
  u16* wt = (u16*)(p.ws + WS_W);
  for (int item = blockIdx.x; item < 384; item += gridDim.x) mods_item(p, item, smem);
  if (blockIdx.x == gridDim.x - 1) {
    float* t16 = (float*)(p.ws + WS_ROPE);
    float* t8 = t16 + 64 * 16 * 2;
    for (int i = ltid(); i < 1024; i += 512) {
      const int pos = i >> 4, j = i & 15;
      const float inv = powf(10000.f, -(float)j / 16.f);
      float s, c; sincosf((float)pos * inv, &s, &c);
      t16[2 * i] = c; t16[2 * i + 1] = s;
    }
    for (int i = ltid(); i < 512; i += 512) {
      const int pos = i >> 3, j = i & 7;
      const float inv = powf(10000.f, -(float)j / 8.f);
      float s, c; sincosf((float)pos * inv, &s, &c);
      t8[2 * i] = c; t8[2 * i + 1] = s;
    }
  }
#pragma unroll 1
  for (int l = 0; l < 4; ++l) {
    transpose_weight(p.in[16] + (size_t)l * 1024 * 4096, wt + W_MLP1 + (size_t)l * 4 * Mi, 1024, 4096, 4096, 0, smem);
    transpose_weight(p.in[17] + (size_t)l * 4096 * 1024, wt + W_MLP2 + (size_t)l * 4 * Mi, 4096, 1024, 1024, 0, smem);
  }
  transpose_weight(p.in[18], wt + W_L0QKV, 1024, 3072, 3072, 0, smem);
  transpose_weight(p.in[21], wt + W_L0O, 1024, 1024, 1024, 0, smem);
  transpose_weight(p.in[22], wt + W_L1QKV, 1024, 3072, 3072, 0, smem);
  transpose_weight(p.in[24], wt + W_L1O, 1024, 1024, 1024, 0, smem);
  transpose_weight(p.in[25], wt + W_L2A, 1024, 800, 1024, 0, smem);
  transpose_weight(p.in[28], wt + W_L2UQ, 512, 1536, 1536, 0, smem);
  transpose_weight(p.in[29], wt + W_L2UKV, 256, 2048, 2048, 1, smem);
  transpose_weight(p.in[30], wt + W_L2O, 1024, 1024, 1024, 0, smem);
  transpose_weight(p.in[31], wt + W_L3QKV, 1024, 1536, 1536, 0, smem);
  transpose_weight(p.in[33], wt + W_L3O, 1024, 1024, 1024, 0, smem);
}

DI int cond_of_row(int row) { return row < NCTX ? 0 : 1 + ((row - NCTX) >> 12); }

DI void h0_pass(const Params& p) {
  const int lane = ltid() & 63;
  const int wid = blockIdx.x * 8 + (ltid() >> 6), nw = gridDim.x * 8;
  const float* mods = (const float*)(p.ws + WS_MODS);
  u16* H = (u16*)(p.ws + WS_H);
  const int rpw = (NTOK + nw - 1) / nw;
  const int r0 = wid * rpw, r1 = min(r0 + rpw, NTOK);
  if (r0 >= r1) return;
  float4 sh[4], sc[4], xv[4];
  int cur_cond = -1;
  {
    const float* x = r0 < NCTX ? p.in[0] + (size_t)r0 * DM : p.in[1] + (size_t)(r0 - NCTX) * DM;
#pragma unroll
    for (int j = 0; j < 4; ++j) { xv[j] = nt_load4(x + j * 256 + lane * 4); sh[j] = make_float4(0.f, 0.f, 0.f, 0.f); sc[j] = sh[j]; }
  }
#pragma unroll 1
  for (int row = r0; row < r1; ++row) {
    const int cnd = cond_of_row(row);
    if (cnd != cur_cond) {
      cur_cond = cnd;
      const float* md = mods + (size_t)cnd * 6144;
#pragma unroll
      for (int j = 0; j < 4; ++j) { sh[j] = *(const float4*)(md + j * 256 + lane * 4); sc[j] = *(const float4*)(md + 1024 + j * 256 + lane * 4); }
    }
    float4 nx[4];
    const int rn = (row + 1 < r1) ? row + 1 : row;
    {
      const float* x = rn < NCTX ? p.in[0] + (size_t)rn * DM : p.in[1] + (size_t)(rn - NCTX) * DM;
#pragma unroll
      for (int j = 0; j < 4; ++j) nx[j] = nt_load4(x + j * 256 + lane * 4);
    }
#pragma unroll
    for (int j = 0; j < 4; ++j) {
      uint2 o;
      o.x = pk2(xv[j].x * (1.f + sc[j].x) + sh[j].x, xv[j].y * (1.f + sc[j].y) + sh[j].y);
      o.y = pk2(xv[j].z * (1.f + sc[j].z) + sh[j].z, xv[j].w * (1.f + sc[j].w) + sh[j].w);
      *(uint2*)(H + (size_t)row * DM + j * 256 + lane * 4) = o;
      uint2 xb; xb.x = pk2(xv[j].x, xv[j].y); xb.y = pk2(xv[j].z, xv[j].w);
      nt_store2((u16*)(p.out + (size_t)row * DM) + j * 256 + lane * 4, xb);
    }
#pragma unroll
    for (int j = 0; j < 4; ++j) xv[j] = nx[j];
  }
}

DI void ln_pass(const Params& p, const u16* y, const float* mods_gate,
                const float* g, const float* bta, const float* mods_next  ) {
  const int lane = ltid() & 63;
  const int wid = blockIdx.x * 8 + (ltid() >> 6), nw = gridDim.x * 8;
  u16* H = (u16*)(p.ws + WS_H);
  const int rpw = (NTOK + nw - 1) / nw;
  const int r0 = wid * rpw, r1 = min(r0 + rpw, NTOK);
  if (r0 >= r1) return;
  float4 gg[4], bb[4], gt[4], sh[4], sc[4];
#pragma unroll
  for (int j = 0; j < 4; ++j) {
    gg[j] = *(const float4*)(g + j * 256 + lane * 4);
    bb[j] = *(const float4*)(bta + j * 256 + lane * 4);
    gt[j] = make_float4(0.f, 0.f, 0.f, 0.f); sh[j] = gt[j]; sc[j] = gt[j];
  }
  int cur_cond = -1;
  auto load_row = [&](int rr, uint2 (&xr)[4], uint2 (&yr)[4]) {
#pragma unroll
    for (int j = 0; j < 4; ++j) {
      xr[j] = nt_load2((const u16*)(p.out + (size_t)rr * DM) + j * 256 + lane * 4);
      yr[j] = nt_load2(y + (size_t)rr * DM + j * 256 + lane * 4);
    }
  };
  auto process = [&](int row, const uint2 (&xv)[4], const uint2 (&yv)[4]) {
    const int cnd = cond_of_row(row);
    if (cnd != cur_cond) {
      cur_cond = cnd;
#pragma unroll
      for (int j = 0; j < 4; ++j) {
        gt[j] = *(const float4*)(mods_gate + (size_t)cnd * 6144 + j * 256 + lane * 4);
        if (mods_next) {
          sh[j] = *(const float4*)(mods_next + (size_t)cnd * 6144 + j * 256 + lane * 4);
          sc[j] = *(const float4*)(mods_next + (size_t)cnd * 6144 + 1024 + j * 256 + lane * 4);
        }
      }
    }
    float v[16];
    float sum = 0.f;
#pragma unroll
    for (int j = 0; j < 4; ++j) {
      v[4 * j + 0] = ALPHA * bf2f((u16)(xv[j].x & 0xffff)) + gt[j].x * bf2f((u16)(yv[j].x & 0xffff));
      v[4 * j + 1] = ALPHA * bf2f((u16)(xv[j].x >> 16)) + gt[j].y * bf2f((u16)(yv[j].x >> 16));
      v[4 * j + 2] = ALPHA * bf2f((u16)(xv[j].y & 0xffff)) + gt[j].z * bf2f((u16)(yv[j].y & 0xffff));
      v[4 * j + 3] = ALPHA * bf2f((u16)(xv[j].y >> 16)) + gt[j].w * bf2f((u16)(yv[j].y >> 16));
      sum += v[4 * j] + v[4 * j + 1] + v[4 * j + 2] + v[4 * j + 3];
    }
#pragma unroll
    for (int o = 32; o > 0; o >>= 1) sum += __shfl_xor(sum, o);
    const float mu = sum * (1.f / 1024.f);
    float sq = 0.f;
#pragma unroll
    for (int i = 0; i < 16; ++i) { const float d = v[i] - mu; sq += d * d; }
#pragma unroll
    for (int o = 32; o > 0; o >>= 1) sq += __shfl_xor(sq, o);
    const float rs = rsqrtf(sq * (1.f / 1024.f) + 1e-5f);
    float* xo = p.out + (size_t)row * DM;
#pragma unroll
    for (int j = 0; j < 4; ++j) {
      const int c = j * 256 + lane * 4;
      float4 xn;
      xn.x = (v[4 * j + 0] - mu) * rs * gg[j].x + bb[j].x;
      xn.y = (v[4 * j + 1] - mu) * rs * gg[j].y + bb[j].y;
      xn.z = (v[4 * j + 2] - mu) * rs * gg[j].z + bb[j].z;
      xn.w = (v[4 * j + 3] - mu) * rs * gg[j].w + bb[j].w;
      if (mods_next) {
        uint2 xb; xb.x = pk2(xn.x, xn.y); xb.y = pk2(xn.z, xn.w);
        nt_store2((u16*)xo + c, xb);
        uint2 o;
        o.x = pk2(xn.x * (1.f + sc[j].x) + sh[j].x, xn.y * (1.f + sc[j].y) + sh[j].y);
        o.y = pk2(xn.z * (1.f + sc[j].z) + sh[j].z, xn.w * (1.f + sc[j].w) + sh[j].w);
        *(uint2*)(H + (size_t)row * DM + c) = o;
      } else {
        nt_store4(xo + c, xn);
      }
    }
  };
  uint2 xa[4], ya[4], xb2[4], yb2[4];
  load_row(r0, xa, ya);
  load_row(min(r0 + 1, r1 - 1), xb2, yb2);
#pragma unroll 1
  for (int row = r0; row < r1; row += 2) {
    uint2 nxa[4], nya[4], nxb[4], nyb[4];
    load_row(min(row + 2, r1 - 1), nxa, nya);
    load_row(min(row + 3, r1 - 1), nxb, nyb);
    process(row, xa, ya);
    if (row + 1 < r1) process(row + 1, xb2, yb2);
#pragma unroll
    for (int j = 0; j < 4; ++j) { xa[j] = nxa[j]; ya[j] = nya[j]; xb2[j] = nxb[j]; yb2[j] = nyb[j]; }
  }
}

DI void mla_norm_pass(const Params& p) {
  const int lane = ltid() & 63;
  const int wid = blockIdx.x * 8 + (ltid() >> 6), nw = gridDim.x * 8;
  const u16* araw = (const u16*)(p.ws + WS_R);
  u16* cqn = (u16*)(p.ws + WS_H);
  u16* ckvn = cqn + (size_t)NTOK * 512;
  u16* kpeb = (u16*)(p.ws + WS_R + R_KPE);
  const float* qn = p.in[26];
  const float* kvn = p.in[27];
  const float* t8 = (const float*)(p.ws + WS_ROPE) + 64 * 16 * 2;
  {
    const int rpw = (NTOK + nw - 1) / nw;
    const int r0 = wid * rpw, r1 = min(r0 + rpw, NTOK);
    const float4 g0 = *(const float4*)(qn + lane * 8);
    const float4 g1 = *(const float4*)(qn + lane * 8 + 4);
    const float4 gk = *(const float4*)(kvn + lane * 4);
    float4 c0 = make_float4(0.f, 0.f, 0.f, 0.f), c1 = c0, k4 = c0; float kp = 0.f;
#define MLA_UNPK(w_, lo_, hi_) do { lo_ = bf2f((u16)((w_) & 0xffff)); hi_ = bf2f((u16)((w_) >> 16)); } while (0)
    if (r0 < r1) {
      const u16* a = araw + (size_t)r0 * 800;
      const uint4 q8 = *(const uint4*)(a + lane * 8); const uint2 q4 = *(const uint2*)(a + 512 + lane * 4);
      MLA_UNPK(q8.x, c0.x, c0.y); MLA_UNPK(q8.y, c0.z, c0.w); MLA_UNPK(q8.z, c1.x, c1.y); MLA_UNPK(q8.w, c1.z, c1.w);
      MLA_UNPK(q4.x, k4.x, k4.y); MLA_UNPK(q4.y, k4.z, k4.w);
      kp = bf2f(a[768 + (lane & 31)]);
    }
#pragma unroll 1
    for (int row = r0; row < r1; ++row) {
      const int rn = (row + 1 < r1) ? row + 1 : row;
      const u16* an = araw + (size_t)rn * 800;
      const uint4 nq8 = *(const uint4*)(an + lane * 8); const uint2 nq4 = *(const uint2*)(an + 512 + lane * 4);
      const u16 nkpw = an[768 + (lane & 31)];
      const bool is_lat = row >= NCTX;
      int krow, t = 0;
      if (is_lat) { const int r2 = row - NCTX; const int b = r2 >> 12; t = r2 & 4095; krow = NCTX + b * LATS + 512 + t; }
      else krow = row;
      float ss = c0.x * c0.x + c0.y * c0.y + c0.z * c0.z + c0.w * c0.w + c1.x * c1.x + c1.y * c1.y + c1.z * c1.z + c1.w * c1.w;
#pragma unroll
      for (int o = 32; o > 0; o >>= 1) ss += __shfl_xor(ss, o);
      float rs = rsqrtf(ss * (1.f / 512.f) + 1e-5f);
      uint4 o;
      o.x = pk2(c0.x * rs * g0.x, c0.y * rs * g0.y); o.y = pk2(c0.z * rs * g0.z, c0.w * rs * g0.w);
      o.z = pk2(c1.x * rs * g1.x, c1.y * rs * g1.y); o.w = pk2(c1.z * rs * g1.z, c1.w * rs * g1.w);
      *(uint4*)(cqn + (size_t)row * 512 + lane * 8) = o;
      float s2 = k4.x * k4.x + k4.y * k4.y + k4.z * k4.z + k4.w * k4.w;
#pragma unroll
      for (int o2 = 32; o2 > 0; o2 >>= 1) s2 += __shfl_xor(s2, o2);
      rs = rsqrtf(s2 * (1.f / 256.f) + 1e-5f);
      float4 kn4;
      kn4.x = k4.x * rs * gk.x; kn4.y = k4.y * rs * gk.y; kn4.z = k4.z * rs * gk.z; kn4.w = k4.w * rs * gk.w;
      uint2 ok2; ok2.x = pk2(kn4.x, kn4.y); ok2.y = pk2(kn4.z, kn4.w);
      *(uint2*)(ckvn + (size_t)krow * 256 + lane * 4) = ok2;
      if (!is_lat) *(float4*)(p.out + O_CKV2 + (size_t)row * 256 + lane * 4) = kn4;
      const int half = (lane >> 3) & 1, jj = lane & 7;
      const float x1 = __shfl(kp, half * 16 + jj), x2 = __shfl(kp, half * 16 + 8 + jj);
      const float nbv = __shfl_xor(kp, 1);
      if (!is_lat) {
        if (lane < 32) {
          p.out[O_KPE2 + (size_t)row * 32 + lane] = kp;
          if ((lane & 1) == 0) *(u32*)(kpeb + (size_t)krow * 32 + lane) = pk2(kp, nbv);
        }
      } else {
        const int pos = half ? (t & 63) : (t >> 6);
        const float cs = t8[(pos * 8 + jj) * 2], sn = t8[(pos * 8 + jj) * 2 + 1];
        const float o1 = x1 * cs - x2 * sn, o2 = x2 * cs + x1 * sn;
        const float n1 = __shfl_xor(o1, 1), n2 = __shfl_xor(o2, 1);
        if (lane < 16 && (lane & 1) == 0) {
          *(u32*)(kpeb + (size_t)krow * 32 + half * 16 + jj) = pk2(o1, n1);
          *(u32*)(kpeb + (size_t)krow * 32 + half * 16 + 8 + jj) = pk2(o2, n2);
        }
      }
      MLA_UNPK(nq8.x, c0.x, c0.y); MLA_UNPK(nq8.y, c0.z, c0.w); MLA_UNPK(nq8.z, c1.x, c1.y); MLA_UNPK(nq8.w, c1.z, c1.w);
      MLA_UNPK(nq4.x, k4.x, k4.y); MLA_UNPK(nq4.y, k4.z, k4.w);
      kp = bf2f(nkpw);
    }
  }
  for (int cr = wid; cr < 4096; cr += nw) {
    const int b = cr >> 9, s = cr & 511;
    const int krow = NCTX + b * LATS + s;
    const float4 k4 = *(const float4*)(p.in[6] + (size_t)cr * 256 + lane * 4);
    uint2 ok2; ok2.x = pk2(k4.x, k4.y); ok2.y = pk2(k4.z, k4.w);
    *(uint2*)(ckvn + (size_t)krow * 256 + lane * 4) = ok2;
    if (lane < 16) {
      const float2 e = *(const float2*)(p.in[7] + (size_t)cr * 32 + lane * 2);
      *(u32*)(kpeb + (size_t)krow * 32 + lane * 2) = pk2(e.x, e.y);
    }
  }
}

DI void cache_convert(const Params& p, const float* ck, const float* cvv, u16* kbuf, u16* vt, int C, int HV, int DV) {
  const int gt = blockIdx.x * 512 + ltid(), ng = gridDim.x * 512;
  const int per_row4 = C >> 2;
  const int total4 = 8 * 512 * per_row4;
  for (int i0 = gt; i0 < total4; i0 += 4 * ng) {
    float4 v[4];
#pragma unroll
    for (int u = 0; u < 4; ++u) { const int i = i0 + u * ng; v[u] = make_float4(0.f, 0.f, 0.f, 0.f); if (i < total4) v[u] = nt_load4(ck + (size_t)i * 4); }
#pragma unroll
    for (int u = 0; u < 4; ++u) {
      const int i = i0 + u * ng;
      if (i < total4) {
        const int cr = i / per_row4, c4 = i - cr * per_row4;
        const int b = cr >> 9, s = cr & 511;
        uint2 o; o.x = pk2(v[u].x, v[u].y); o.y = pk2(v[u].z, v[u].w);
        *(uint2*)(kbuf + (size_t)(NCTX + b * LATS + s) * C + c4 * 4) = o;
      }
    }
  }
  const int CV = HV * DV;
  const int totalv = 8 * 16 * 8 * CV;
  u16* vlat = vt + (size_t)NCTX * CV;
  for (int i0 = gt; i0 < totalv; i0 += 4 * ng) {
    float a[4][4];
#pragma unroll
    for (int u = 0; u < 4; ++u) {
      const int i = i0 + u * ng;
      a[u][0] = a[u][1] = a[u][2] = a[u][3] = 0.f;
      if (i < totalv) {
        const int col = i % CV; int r = i / CV;
        const int kq = r & 7; r >>= 3;
        const int tile = r & 15; const int b = r >> 4;
        const float* src = cvv + ((size_t)(b * 512 + tile * 32 + kq * 4)) * CV + col;
        a[u][0] = src[0]; a[u][1] = src[CV]; a[u][2] = src[2 * (size_t)CV]; a[u][3] = src[3 * (size_t)CV];
      }
    }
#pragma unroll
    for (int u = 0; u < 4; ++u) {
      const int i = i0 + u * ng;
      if (i < totalv) {
        const int col = i % CV; int r = i / CV;
        const int kq = r & 7; r >>= 3;
        const int tile = r & 15; const int b = r >> 4;
        const int hv = col / DV, dv = col - hv * DV;
        uint2 o; o.x = pk2(a[u][0], a[u][1]); o.y = pk2(a[u][2], a[u][3]);
        *(uint2*)(vlat + ((size_t)((b * HV + hv) * 144 + tile) * DV + dv) * 32 + kq * 4) = o;
      }
    }
  }
}


#define PG8_LAS __attribute__((address_space(3)))
typedef float f32x4 __attribute__((ext_vector_type(4)));
constexpr int BM = 256, BK = 64, HALF = 128, HTB = HALF * BK * 2, STAGE_BYTES = 8 * HTB, NXCD = 8, WGM = 8;
DI int lds_byte(int r, int c) { const int st = (r >> 4) * 2 + (c >> 5), rr = r & 15, cc = c & 31, ob = rr * 64 + cc * 2; return st * 1024 + (ob ^ (((ob >> 9) & 1) << 5)); }
DI void stage_rc(int b, int& R, int& C) { const int st = b / 1024, sb = b % 1024, swz = sb ^ (((sb >> 9) & 1) << 5); R = (st >> 1) * 16 + swz / 64; C = (st & 1) * 32 + (swz % 64) / 2; }
DI int perm32(int rho) { const int n = rho >> 4, i = rho & 15; return 8 * (i >> 2) + 4 * n + (i & 3); }

struct Unit { int pm, pn, kind; };
struct Sched2 {
  const char* act; const char* w; size_t tstep, w1off;
  int K, nM0, nN0, nM1, n0, n1, G, c;
  DI void map(int wgid, int nM, int nN, int& pm, int& pn) const {
    const int nwg = nM * nN;
    { const int q = nwg / NXCD, r = nwg % NXCD, xcd = wgid % NXCD, off = wgid / NXCD; wgid = (xcd < r ? xcd * (q + 1) : r * (q + 1) + (xcd - r) * q) + off; }
    const int nig = WGM * nN, gid = wgid / nig, fm = gid * WGM, gsz = (nM - fm) < WGM ? (nM - fm) : WGM;
    pm = fm + ((wgid % nig) % gsz); pn = (wgid % nig) / gsz;
  }
  DI bool next(int i, Unit& u) const {
    int L = i * G + c;
    if (L < n0) { map(L, nM0, nN0, u.pm, u.pn); u.kind = 0; return true; }
    L -= n0;
    if (L < n1) { map(L, nM1, nM0, u.pm, u.pn); u.kind = 1; return true; }
    return false;
  }
  DI const char* abase(const Unit& u) const { return u.kind == 0 ? act + (size_t)u.pm * tstep : w + w1off + (size_t)u.pm * tstep; }
  DI const char* bbase(const Unit& u) const { return u.kind == 0 ? w + (size_t)u.pn * tstep : act + (size_t)u.pn * tstep; }
};

DI void rope64p(float (&v)[8], int parity, int t, int fq, const float* t16) {
  const int pos = parity ? (t & 63) : (t >> 6);
  const float* tb = t16 + (pos * 16 + 8 * (fq & 1)) * 2;
#pragma unroll
  for (int q4 = 0; q4 < 4; ++q4) {
    const float4 cs = *(const float4*)(tb + q4 * 4);
    const float p0 = __shfl_xor(v[2 * q4], 32), p1 = __shfl_xor(v[2 * q4 + 1], 32);
    if (fq < 2) { v[2 * q4] = v[2 * q4] * cs.x - p0 * cs.y; v[2 * q4 + 1] = v[2 * q4 + 1] * cs.z - p1 * cs.w; }
    else { v[2 * q4] = v[2 * q4] * cs.x + p0 * cs.y; v[2 * q4 + 1] = v[2 * q4 + 1] * cs.z + p1 * cs.w; }
  }
}
DI void rope32p(float (&v)[8], int t, int fq, const float* t8) {
  const int pos = (fq < 2) ? (t >> 6) : (t & 63);
  const float* tb = t8 + (pos * 8) * 2;
#pragma unroll
  for (int q4 = 0; q4 < 4; ++q4) {
    const float4 cs = *(const float4*)(tb + q4 * 4);
    const float p0 = __shfl_xor(v[2 * q4], 16), p1 = __shfl_xor(v[2 * q4 + 1], 16);
    if ((fq & 1) == 0) { v[2 * q4] = v[2 * q4] * cs.x - p0 * cs.y; v[2 * q4 + 1] = v[2 * q4 + 1] * cs.z - p1 * cs.w; }
    else { v[2 * q4] = v[2 * q4] * cs.x + p0 * cs.y; v[2 * q4 + 1] = v[2 * q4 + 1] * cs.z + p1 * cs.w; }
  }
}

struct GJ {
  int nvalid, n_k0, kspace;
  u16* oq; int ldq; int qrope; float qscale; int relu2; float* of32; int ldf32;
  int simple;
  u16* ok; int ldk; int krope; float* kst; int ldkst;
  u16* ovt; int HV; int dvshift; float* vst; int ldvst;
  const float* t16; const float* t8;
};

struct Epi2 {
  static constexpr bool PERM = true;
  GJ j;
  DI void operator()(const f32x4 (&acc)[2][2][4][2], const Unit& u, int wr, int wc, int fr_, int fq_) const {
    int ln = fr_ + 16 * fq_;
    asm volatile("" : "+v"(ln));
    const int fr = ln & 15, fq = ln >> 4;
    if (j.simple) {
      typedef unsigned u32x4_t __attribute__((ext_vector_type(4)));
      u16* const ob = j.oq + (size_t)(u.pm * 256 + wr * 64 + fr) * j.ldq + u.pn * 256 + wc * 32 + fq * 8;
#pragma unroll
      for (int ai = 0; ai < 2; ++ai)
#pragma unroll
        for (int m = 0; m < 4; ++m)
#pragma unroll
          for (int bj = 0; bj < 2; ++bj) {
            float v[8];
#pragma unroll
            for (int jj = 0; jj < 4; ++jj) { v[jj] = acc[ai][bj][m][0][jj]; v[4 + jj] = acc[ai][bj][m][1][jj]; }
            if (j.relu2) {
#pragma unroll
              for (int i = 0; i < 8; ++i) { const float r = fmaxf(v[i], 0.f); v[i] = r * r; }
            }
            const u32x4_t o = {pk2(v[0], v[1]), pk2(v[2], v[3]), pk2(v[4], v[5]), pk2(v[6], v[7])};
            u32x4_t* dst = (u32x4_t*)(ob + (size_t)(ai * 128 + m * 16) * j.ldq + bj * 128);
            if (j.relu2) __builtin_nontemporal_store(o, dst); else *dst = o;
          }
      return;
    }
    if (u.kind == 0) {
      const bool is_lat = (u.pm * 256 >= NCTX);
      const bool qtype = (u.pn * 256 < j.n_k0);
      const bool rope_q = is_lat && (j.qrope == 1), rope_q2 = is_lat && (j.qrope == 2), rope_k = is_lat && (j.krope != 0);
      const bool kstate = (j.kst != nullptr) && !is_lat;
#pragma unroll
      for (int ai = 0; ai < 2; ++ai)
#pragma unroll
        for (int m = 0; m < 4; ++m) {
          const int row = u.pm * 256 + ai * 128 + wr * 64 + m * 16 + fr;
          int t = 0, krow = row;
          if (!j.kspace && is_lat) { const int r2 = row - NCTX; const int b = r2 >> 12; t = r2 & 4095; krow = NCTX + b * LATS + 512 + t; }
#pragma unroll
          for (int bj = 0; bj < 2; ++bj) {
            const int c8 = u.pn * 256 + bj * 128 + wc * 32 + fq * 8;
            float v[8];
#pragma unroll
            for (int jj = 0; jj < 4; ++jj) { v[jj] = acc[ai][bj][m][0][jj]; v[4 + jj] = acc[ai][bj][m][1][jj]; }
            if (qtype) {
              if (rope_q) rope64p(v, (c8 >> 5) & 1, t, fq, j.t16);
              if (rope_q2 && (((u.pn * 8 + bj * 4 + wc) % 3) == 2)) rope32p(v, t, fq, j.t8);
              if (j.of32) {
                if (c8 < j.nvalid) {
                  *(float4*)(j.of32 + (size_t)row * j.ldf32 + c8) = make_float4(v[0], v[1], v[2], v[3]);
                  *(float4*)(j.of32 + (size_t)row * j.ldf32 + c8 + 4) = make_float4(v[4], v[5], v[6], v[7]);
                }
              } else {
                const float qs = j.qscale;
                uint4 o; o.x = pk2(v[0] * qs, v[1] * qs); o.y = pk2(v[2] * qs, v[3] * qs); o.z = pk2(v[4] * qs, v[5] * qs); o.w = pk2(v[6] * qs, v[7] * qs);
                if (c8 < j.nvalid) *(uint4*)(j.oq + (size_t)row * j.ldq + c8) = o;
              }
            } else {
              const int fk = c8 - j.n_k0;
              if (kstate) {
                *(float4*)(j.kst + (size_t)row * j.ldkst + fk) = make_float4(v[0], v[1], v[2], v[3]);
                *(float4*)(j.kst + (size_t)row * j.ldkst + fk + 4) = make_float4(v[4], v[5], v[6], v[7]);
              }
              if (rope_k) rope64p(v, (c8 >> 5) & 1, t, fq, j.t16);
              uint4 o; o.x = pk2(v[0], v[1]); o.y = pk2(v[2], v[3]); o.z = pk2(v[4], v[5]); o.w = pk2(v[6], v[7]);
              *(uint4*)(j.ok + (size_t)krow * j.ldk + fk) = o;
            }
            asm volatile("" ::: "memory");
          }
        }
    } else {
      const int DV = 1 << j.dvshift;
      const int tok0 = u.pn * 256;
      const bool is_lat = tok0 >= NCTX;
      int bb, s0, nt; size_t sbase;
      if (is_lat) {
        const int r2 = tok0 - NCTX;
        if (j.kspace) { bb = r2 / LATS; s0 = r2 - bb * LATS; } else { bb = r2 >> 12; s0 = 512 + (r2 & 4095); }
        nt = 144; sbase = (size_t)NCTX * j.HV * DV;
      } else { bb = tok0 >> 8; s0 = 0; nt = 8; sbase = 0; }
      const bool vstate = (j.vst != nullptr) && !is_lat;
#pragma unroll
      for (int ai = 0; ai < 2; ++ai)
#pragma unroll
        for (int m = 0; m < 4; ++m) {
          const int f = u.pm * 256 + ai * 128 + wr * 64 + m * 16 + fr;
          const int hv = f >> j.dvshift, dv = f & (DV - 1);
          u16* const vrow = j.ovt + sbase + ((size_t)((bb * j.HV + hv) * nt) * DV + dv) * 32;
#pragma unroll
          for (int bj = 0; bj < 2; ++bj) {
            const int tl = bj * 128 + wc * 32 + fq * 8;
            const int s = s0 + tl;
            uint4 o;
            o.x = pk2(acc[ai][bj][m][0][0], acc[ai][bj][m][0][1]); o.y = pk2(acc[ai][bj][m][0][2], acc[ai][bj][m][0][3]);
            o.z = pk2(acc[ai][bj][m][1][0], acc[ai][bj][m][1][1]); o.w = pk2(acc[ai][bj][m][1][2], acc[ai][bj][m][1][3]);
            *(uint4*)(vrow + (size_t)(s >> 5) * DV * 32 + (s & 31)) = o;
            if (vstate) {
#pragma unroll
              for (int n2 = 0; n2 < 2; ++n2)
#pragma unroll
                for (int jj = 0; jj < 4; ++jj) j.vst[(size_t)(tok0 + tl + 4 * n2 + jj) * j.ldvst + f] = acc[ai][bj][m][n2][jj];
            }
            asm volatile("" ::: "memory");
          }
        }
    }
  }
};

DI void gemm_phase(PG8_LAS unsigned char* lds, const Sched2& S, const Epi2& E) {
  const int tid = ltid(), wid = __builtin_amdgcn_readfirstlane(tid >> 6), lane = tid & 63, wr = wid >> 2, wc = wid & 3, fr = lane & 15, fq = lane >> 4;
  const int K = S.K, nt = K / BK;
  unsigned voffA[2], voffB[2];
#pragma unroll
  for (int i = 0; i < 2; ++i) { int R, C; stage_rc(tid * 16 + i * 8192, R, C); const int Rb = (R & ~31) + perm32(R & 31);
    voffA[i] = (unsigned)(R * K + C) * 2u; voffB[i] = (unsigned)(Rb * K + C) * 2u; }
  const size_t kstep = (size_t)(BK * 2);
  const size_t hstep = (size_t)HALF * K * 2;
  const unsigned ldsw = (unsigned)wid * 1024u;
  const int aoff = lds_byte(wr * 64 + fr, fq * 8), boff = lds_byte(wc * 32 + fr, fq * 8);
#define PG8_SA(b, h) (((b) * 2 + (h)) * HTB)
#define PG8_SB(b, h) ((4 + (b) * 2 + (h)) * HTB)
#define PG8_STAGE(bufoff, gbase, voff) do { _Pragma("unroll") for (int _i = 0; _i < 2; ++_i) \
        __builtin_amdgcn_global_load_lds((const unsigned*)((const char*)(gbase) + (voff)[_i]), (PG8_LAS unsigned*)(lds + (bufoff) + ldsw + _i * 8192), 16, 0, 0); } while (0)
#define PG8_LDA(dst, b, h) do { _Pragma("unroll") for (int m = 0; m < 4; ++m) _Pragma("unroll") for (int k = 0; k < 2; ++k) dst[m][k] = *(const PG8_LAS bf16x8*)(lds + PG8_SA(b, h) + aoff + m * 2048 + k * 1024); } while (0)
#define PG8_LDB(dst, b, h) do { _Pragma("unroll") for (int n = 0; n < 2; ++n) _Pragma("unroll") for (int k = 0; k < 2; ++k) dst[n][k] = *(const PG8_LAS bf16x8*)(lds + PG8_SB(b, h) + boff + n * 2048 + k * 1024); } while (0)
#define PG8_MMA(ai, bj, At, Bt) do { __builtin_amdgcn_s_setprio(1); _Pragma("unroll") for (int m = 0; m < 4; ++m) _Pragma("unroll") for (int n = 0; n < 2; ++n) _Pragma("unroll") for (int k = 0; k < 2; ++k) \
        acc[ai][bj][m][n] = __builtin_amdgcn_mfma_f32_16x16x32_bf16(Bt[n][k], At[m][k], acc[ai][bj][m][n], 0, 0, 0); __builtin_amdgcn_s_setprio(0); } while (0)
#define PG8_WAIT_V(n) asm volatile("s_waitcnt vmcnt(" #n ")" ::: "memory")
#define PG8_WAIT_L(n) asm volatile("s_waitcnt lgkmcnt(" #n ")" ::: "memory")
#define PG8_BAR __builtin_amdgcn_s_barrier()
#define PG8_SCHED __builtin_amdgcn_sched_barrier(0)
  Unit cur, nxt; int ui = 0;
  if (!S.next(0, cur)) return;
  f32x4 acc[2][2][4][2];
#pragma unroll
  for (int a = 0; a < 2; ++a)
#pragma unroll
    for (int b = 0; b < 2; ++b)
#pragma unroll
      for (int m = 0; m < 4; ++m)
#pragma unroll
        for (int n = 0; n < 2; ++n) acc[a][b][m][n] = (f32x4){0.f, 0.f, 0.f, 0.f};
  bf16x8 At[4][2], B0[2][2], B1[2][2];
  const char* cA = S.abase(cur); const char* cB = S.bbase(cur);
  PG8_STAGE(PG8_SB(0, 0), cB, voffB); PG8_STAGE(PG8_SA(0, 0), cA, voffA); PG8_STAGE(PG8_SB(0, 1), cB + hstep, voffB); PG8_STAGE(PG8_SA(0, 1), cA + hstep, voffA);
  if (wr == 1) PG8_BAR;
  PG8_WAIT_V(4); PG8_BAR;
  PG8_STAGE(PG8_SB(1, 0), cB + kstep, voffB); PG8_STAGE(PG8_SA(1, 0), cA + kstep, voffA); PG8_STAGE(PG8_SB(1, 1), cB + hstep + kstep, voffB);
  PG8_WAIT_V(6); PG8_BAR;
  for (;;) {
    const bool has_next = S.next(ui + 1, nxt);
    const char* nA = has_next ? S.abase(nxt) : cA; const char* nB = has_next ? S.bbase(nxt) : cB;
    for (int t = 0; t < nt; t += 2) {
      const bool last = (t == nt - 2);
      const char* a1 = cA + (size_t)(t + 1) * kstep;
      const char* a2 = last ? nA : cA + (size_t)(t + 2) * kstep; const char* b2 = last ? nB : cB + (size_t)(t + 2) * kstep;
      const char* a3 = a2 + kstep; const char* b3 = b2 + kstep;
      PG8_LDB(B0, 0, 0); PG8_SCHED; PG8_LDA(At, 0, 0); PG8_STAGE(PG8_SA(1, 1), a1 + hstep, voffA);
      PG8_WAIT_L(8); PG8_BAR; PG8_WAIT_L(0); PG8_MMA(0, 0, At, B0); PG8_BAR; PG8_SCHED;
      PG8_LDB(B1, 0, 1); PG8_STAGE(PG8_SB(0, 0), b2, voffB);
      PG8_BAR; PG8_WAIT_L(0); PG8_MMA(0, 1, At, B1); PG8_BAR;
      PG8_LDA(At, 0, 1); PG8_STAGE(PG8_SA(0, 0), a2, voffA);
      PG8_BAR; PG8_WAIT_L(0); PG8_MMA(1, 0, At, B0); PG8_BAR; PG8_SCHED;
      PG8_STAGE(PG8_SB(0, 1), b2 + hstep, voffB);
      PG8_WAIT_V(6); PG8_BAR; PG8_MMA(1, 1, At, B1); PG8_BAR;
      PG8_LDB(B0, 1, 0); PG8_SCHED; PG8_LDA(At, 1, 0); PG8_STAGE(PG8_SA(0, 1), a2 + hstep, voffA);
      PG8_WAIT_L(8); PG8_BAR; PG8_WAIT_L(0); PG8_MMA(0, 0, At, B0); PG8_BAR; PG8_SCHED;
      PG8_LDB(B1, 1, 1); PG8_STAGE(PG8_SB(1, 0), b3, voffB);
      PG8_BAR; PG8_WAIT_L(0); PG8_MMA(0, 1, At, B1); PG8_BAR;
      PG8_LDA(At, 1, 1); PG8_STAGE(PG8_SA(1, 0), a3, voffA);
      PG8_BAR; PG8_WAIT_L(0); PG8_MMA(1, 0, At, B0); PG8_BAR; PG8_SCHED;
      PG8_STAGE(PG8_SB(1, 1), b3 + hstep, voffB);
      PG8_WAIT_V(6); PG8_BAR; PG8_MMA(1, 1, At, B1); PG8_BAR;
    }
    E(acc, cur, wr, wc, fr, fq);
    if (!has_next) break;
#pragma unroll
    for (int a = 0; a < 2; ++a)
#pragma unroll
      for (int b = 0; b < 2; ++b)
#pragma unroll
        for (int m = 0; m < 4; ++m)
#pragma unroll
          for (int n = 0; n < 2; ++n) acc[a][b][m][n] = (f32x4){0.f, 0.f, 0.f, 0.f};
    cur = nxt; cA = nA; cB = nB; ++ui;
  }
  PG8_WAIT_V(0);
  if (wr == 0) PG8_BAR;
  PG8_BAR;
#undef PG8_SA
#undef PG8_SB
#undef PG8_STAGE
#undef PG8_LDA
#undef PG8_LDB
#undef PG8_MMA
#undef PG8_WAIT_V
#undef PG8_WAIT_L
#undef PG8_BAR
#undef PG8_SCHED
}

DI GJ gj_base(const Params& p) {
  GJ j;
  j.nvalid = 1 << 30; j.n_k0 = 1 << 30; j.kspace = 0;
  j.oq = nullptr; j.ldq = 1024; j.qrope = 0; j.qscale = 1.f; j.relu2 = 0; j.of32 = nullptr; j.ldf32 = 0; j.simple = 0;
  j.ok = nullptr; j.ldk = 1024; j.krope = 0; j.kst = nullptr; j.ldkst = 0;
  j.ovt = nullptr; j.HV = 16; j.dvshift = 6; j.vst = nullptr; j.ldvst = 0;
  j.t16 = (const float*)(p.ws + WS_ROPE); j.t8 = j.t16 + 64 * 16 * 2;
  return j;
}
constexpr int ATT_PARK = 90112;
template <int KS, int MT, int MODE, bool MLA, int EPI>
DI void attn_block(char* smem, const u16* __restrict__ qp, const u16* __restrict__ kp, int ldk, const u16* __restrict__ kpe,
                   const u16* __restrict__ vp, u16* __restrict__ op, int nst, int win_pos0, float m_init, float l_init,
                   int r, int r0, int c, const float* sbias, int tq0, float lam, const float* subln, u32* park) {
  constexpr int DV = MT * 32;
  constexpr int KSTR = KS * 32 + 16;
  constexpr int VOFF = 64 * KSTR;
  constexpr int STAGE = VOFF + 2 * DV * 80;
  constexpr int NVC = (2 * DV * 4) / 512;
  const int tid = ltid(), lane = tid & 63, n = lane & 31, hh = lane >> 5;
  const int kperm = (n & 16) + 8 * ((n >> 2) & 1) + 4 * ((n >> 3) & 1) + (n & 3);
  bf16x8 qf[KS];
#pragma unroll
  for (int ks = 0; ks < KS; ++ks) qf[ks] = __builtin_nontemporal_load((const bf16x8*)(qp + ks * 16 + hh * 8));
  f32x16 O[MT];
  float m = m_init, l = l_init;
#pragma unroll
  for (int mt = 0; mt < MT; ++mt)
#pragma unroll
    for (int i = 0; i < 16; ++i) O[mt][i] = 0.f;
  const int c0 = min(max(c - 8, 0), 48);
  const int tq = tq0 + n;
  const int krow_l = tid >> 3, kpart = tid & 7;
  const int perow = tid >> 2, pepart = tid & 3;
  const int vsub0 = tid / (DV * 4), vrem0 = tid - vsub0 * (DV * 4);
  const int vsrc0 = vsub0 * (DV * 32) + (vrem0 >> 2) * 32 + (vrem0 & 3) * 8;
  const int vdst0 = VOFF + (vsub0 * DV + (vrem0 >> 2)) * 80 + (vrem0 & 3) * 16;
  const int vsrc1 = vsrc0 + DV * 32, vdst1 = vdst0 + DV * 80;
  uint4 rk, rpe = make_uint4(0, 0, 0, 0), rv0, rv1 = make_uint4(0, 0, 0, 0);
#define ATT_GLOAD(i_) do { const int p0_ = (MODE == 0 || (i_) < 8) ? (i_) * 64 : win_pos0 + ((i_) - 8) * 64; \
    rk = *(const uint4*)(kp + (size_t)(p0_ + krow_l) * ldk + kpart * 8); \
    if (MLA && tid < 256) rpe = *(const uint4*)(kpe + (size_t)(p0_ + perow) * 32 + pepart * 8); \
    rv0 = *(const uint4*)(vp + (size_t)(p0_ >> 5) * (DV * 32) + vsrc0); \
    if (NVC == 2) rv1 = *(const uint4*)(vp + (size_t)(p0_ >> 5) * (DV * 32) + vsrc1); } while (0)
#define ATT_SSTORE(buf_) do { char* sb_ = smem + (buf_) * STAGE; \
    *(uint4*)(sb_ + krow_l * KSTR + kpart * 16) = rk; \
    if (MLA && tid < 256) *(uint4*)(sb_ + perow * KSTR + 128 + pepart * 16) = rpe; \
    *(uint4*)(sb_ + vdst0) = rv0; \
    if (NVC == 2) *(uint4*)(sb_ + vdst1) = rv1; } while (0)
  __syncthreads();
  ATT_GLOAD(0); ATT_SSTORE(0);
  __syncthreads();
#pragma unroll 1
  for (int i = 0; i < nst; ++i) {
    if (i + 1 < nst) ATT_GLOAD(i + 1);
    const char* sb = smem + (i & 1) * STAGE;
    const int pos0 = (MODE == 0 || i < 8) ? i * 64 : win_pos0 + (i - 8) * 64;
    const bool special = (MODE != 0) && (i >= 8);
    {
      int keyrow = 0, t0 = 0;
      bool use0 = true, use1 = true;
      if (MODE == 1 && special) { keyrow = (pos0 - 512) >> 6; use0 = use1 = (keyrow >= r0) && (keyrow < r0 + 8); }
      if (MODE == 2 && special) { t0 = pos0 - 512; use0 = (t0 >= tq0 - 128) && (t0 <= tq0 + 128); use1 = (t0 + 32 >= tq0 - 128) && (t0 + 32 <= tq0 + 128); }
      if (use0 || use1) {
        f32x16 S0, S1;
#pragma unroll
        for (int q = 0; q < 16; ++q) { S0[q] = 0.f; S1[q] = 0.f; }
        {
          bf16x8 kf[2][KS];
#pragma unroll
          for (int ks = 0; ks < KS; ++ks) {
            kf[0][ks] = *(const bf16x8*)(sb + kperm * KSTR + ks * 32 + hh * 16);
            kf[1][ks] = *(const bf16x8*)(sb + (32 + kperm) * KSTR + ks * 32 + hh * 16);
          }
          __builtin_amdgcn_sched_barrier(0);
#pragma unroll
          for (int ks = 0; ks < KS; ++ks) {
            S0 = MFMA(kf[0][ks], qf[ks], S0);
            S1 = MFMA(kf[1][ks], qf[ks], S1);
          }
        }
        bf16x8 vfa[2][MT];
#pragma unroll
        for (int s = 0; s < 2; ++s)
#pragma unroll
          for (int mt = 0; mt < MT; ++mt) vfa[s][mt] = *(const bf16x8*)(sb + VOFF + (mt * 32 + n) * 80 + s * 32 + hh * 16);
        __builtin_amdgcn_sched_barrier(0);
        float sv[32];
#pragma unroll
        for (int q = 0; q < 16; ++q) { sv[q] = S0[q]; sv[16 + q] = S1[q]; }
        if (MODE == 1 && special) {
#pragma unroll
          for (int q = 0; q < 32; ++q) {
            const int keycol = 32 * (q >> 4) + 16 * ((q >> 3) & 1) + 8 * hh + (q & 7);
            const bool valid = (unsigned)(keycol - c0) < 16u;
            int bi = (keyrow - r + 7) * 31 + (keycol - c + 15);
            bi = min(max(bi, 0), 464);
            const float bv = sbias[bi];
            sv[q] = valid ? sv[q] + bv : -1e30f;
          }
        }
        if (MODE == 2 && special) {
#pragma unroll
          for (int q = 0; q < 32; ++q) {
            const int d = t0 + 32 * (q >> 4) + 16 * ((q >> 3) & 1) + 8 * hh + (q & 7) - tq;
            sv[q] = (d >= -128 && d <= 128) ? sv[q] : -1e30f;
          }
        }
        float mx = sv[0];
#pragma unroll
        for (int q = 1; q < 32; ++q) mx = fmaxf(mx, sv[q]);
        mx = fmaxf(mx, __shfl_xor(mx, 32));
        const float mnew = fmaxf(m, mx);
        if (__any(mnew > m)) {
          const float alpha = ex2(m - mnew);
          l *= alpha;
#pragma unroll
          for (int mt = 0; mt < MT; ++mt)
#pragma unroll
            for (int q = 0; q < 16; ++q) O[mt][q] *= alpha;
        }
        m = mnew;
        float rs = 0.f;
#pragma unroll
        for (int q = 0; q < 32; ++q) { sv[q] = ex2(sv[q] - mnew); rs += sv[q]; }
        l += rs;
        bf16x8 pf[4];
#pragma unroll
        for (int s = 0; s < 4; ++s) {
          const u32 w0 = pk2(sv[8 * s + 0], sv[8 * s + 1]), w1 = pk2(sv[8 * s + 2], sv[8 * s + 3]);
          const u32 w2 = pk2(sv[8 * s + 4], sv[8 * s + 5]), w3 = pk2(sv[8 * s + 6], sv[8 * s + 7]);
          const uint4 pw = make_uint4(w0, w1, w2, w3);
          pf[s] = __builtin_bit_cast(bf16x8, pw);
        }
        bf16x8 vfb[2][MT];
#pragma unroll
        for (int s = 0; s < 2; ++s)
#pragma unroll
          for (int mt = 0; mt < MT; ++mt) vfb[s][mt] = *(const bf16x8*)(sb + VOFF + (DV + mt * 32 + n) * 80 + s * 32 + hh * 16);
        __builtin_amdgcn_sched_barrier(0);
#pragma unroll
        for (int s = 0; s < 2; ++s)
#pragma unroll
          for (int mt = 0; mt < MT; ++mt) O[mt] = MFMA(vfa[s][mt], pf[s], O[mt]);
#pragma unroll
        for (int s = 0; s < 2; ++s)
#pragma unroll
          for (int mt = 0; mt < MT; ++mt) O[mt] = MFMA(vfb[s][mt], pf[2 + s], O[mt]);
      }
    }
    if (i + 1 < nst) ATT_SSTORE((i + 1) & 1);
    __syncthreads();
  }
#undef ATT_GLOAD
#undef ATT_SSTORE
  const float inv = 1.f / (l + __shfl_xor(l, 32));
  if (EPI == 0) {
#pragma unroll
    for (int mt = 0; mt < MT; ++mt)
#pragma unroll
      for (int g = 0; g < 4; ++g) {
        uint2 o;
        o.x = pk2(O[mt][4 * g] * inv, O[mt][4 * g + 1] * inv);
        o.y = pk2(O[mt][4 * g + 2] * inv, O[mt][4 * g + 3] * inv);
        *(uint2*)(op + mt * 32 + 8 * g + 4 * hh) = o;
      }
  } else if (EPI == 1) {
#pragma unroll
    for (int mt = 0; mt < MT; ++mt)
#pragma unroll
      for (int q = 0; q < 8; ++q) park[(mt * 8 + q) * 64 + lane] = pk2(O[mt][2 * q] * inv, O[mt][2 * q + 1] * inv);
  } else {
    float ss = 0.f;
    const float li = lam * inv;
#pragma unroll
    for (int mt = 0; mt < MT; ++mt) {
#pragma unroll
      for (int q = 0; q < 8; ++q) {
        const u32 pw = park[(mt * 8 + q) * 64 + lane];
        const float v0 = bf2f((u16)(pw & 0xffff)) - li * O[mt][2 * q];
        const float v1 = bf2f((u16)(pw >> 16)) - li * O[mt][2 * q + 1];
        O[mt][2 * q] = v0; O[mt][2 * q + 1] = v1; ss += v0 * v0 + v1 * v1;
      }
      asm volatile("" ::: "memory");
    }
    ss += __shfl_xor(ss, 32);
    const float rn = rsqrtf(ss * (1.f / (MT * 32)) + 1e-5f) * 0.8f;
#pragma unroll
    for (int mt = 0; mt < MT; ++mt)
#pragma unroll
      for (int g = 0; g < 4; ++g) {
        const float4 sg = *(const float4*)(subln + mt * 32 + 8 * g + 4 * hh);
        uint2 o;
        o.x = pk2(O[mt][4 * g] * rn * sg.x, O[mt][4 * g + 1] * rn * sg.y);
        o.y = pk2(O[mt][4 * g + 2] * rn * sg.z, O[mt][4 * g + 3] * rn * sg.w);
        *(uint2*)(op + mt * 32 + 8 * g + 4 * hh) = o;
      }
  }
}

#define ATT_PIN(x) asm volatile("" : "+v"(x))
template <int KS, int MT, bool MLA, int EPI, int MODE = 0>
DI void attn_block_dense(char* smem, const u16* __restrict__ qp, const u16* __restrict__ kp, int ldk, const u16* __restrict__ kpe,
                         const u16* __restrict__ vp, u16* __restrict__ op, int nst, float m_init, float l_init,
                         float lam, const float* subln, u32* park,
                         int win_pos0 = 0, int r = 0, int r0 = 0, int c = 0, const float* sbias = nullptr, int tq0 = 0) {
  constexpr int DV = MT * 32;
  constexpr int KSTR = KS * 32 + 16;
  constexpr int VOFF = 64 * KSTR;
  constexpr int STAGE = VOFF + 2 * DV * 80;
  constexpr int NVC = (2 * DV * 4) / 512;
  constexpr int NA = 2 * KS, NB = 4 * MT;
  const int tid = ltid(), lane = tid & 63, n = lane & 31, hh = lane >> 5;
  const int kperm = (n & 16) + 8 * ((n >> 2) & 1) + 4 * ((n >> 3) & 1) + (n & 3);
  bf16x8 qf[KS];
#pragma unroll
  for (int ks = 0; ks < KS; ++ks) qf[ks] = __builtin_nontemporal_load((const bf16x8*)(qp + ks * 16 + hh * 8));
  f32x16 O[MT];
  float m = m_init, l = l_init;
#pragma unroll
  for (int mt = 0; mt < MT; ++mt)
#pragma unroll
    for (int i = 0; i < 16; ++i) O[mt][i] = 0.f;
  const int krow_l = tid >> 3, kpart = tid & 7;
  const int perow = tid >> 2, pepart = tid & 3;
  const int vsub0 = tid / (DV * 4), vrem0 = tid - vsub0 * (DV * 4);
  const int vsrc0 = vsub0 * (DV * 32) + (vrem0 >> 2) * 32 + (vrem0 & 3) * 8;
  const int vdst0 = VOFF + (vsub0 * DV + (vrem0 >> 2)) * 80 + (vrem0 & 3) * 16;
  const int vsrc1 = vsrc0 + DV * 32, vdst1 = vdst0 + DV * 80;
  const int koff = kperm * KSTR + hh * 16;
  const int voff = VOFF + n * 80 + hh * 16;
  uint4 rk, rpe = make_uint4(0, 0, 0, 0), rv0, rv1 = make_uint4(0, 0, 0, 0);
#define ATD_GLOAD(i_) do { const int p0_ = (MODE == 0 || (i_) < 8) ? (i_) * 64 : win_pos0 + ((i_) - 8) * 64; \
    rk = *(const uint4*)(kp + (size_t)(p0_ + krow_l) * ldk + kpart * 8); \
    if (MLA && tid < 256) rpe = *(const uint4*)(kpe + (size_t)(p0_ + perow) * 32 + pepart * 8); \
    rv0 = *(const uint4*)(vp + (size_t)(p0_ >> 5) * (DV * 32) + vsrc0); \
    if (NVC == 2) rv1 = *(const uint4*)(vp + (size_t)(p0_ >> 5) * (DV * 32) + vsrc1); } while (0)
#define ATD_SSTORE(sb_) do { \
    *(uint4*)((sb_) + krow_l * KSTR + kpart * 16) = rk; \
    if (MLA && tid < 256) *(uint4*)((sb_) + perow * KSTR + 128 + pepart * 16) = rpe; \
    *(uint4*)((sb_) + vdst0) = rv0; \
    if (NVC == 2) *(uint4*)((sb_) + vdst1) = rv1; } while (0)
  __syncthreads();
  ATD_GLOAD(0); ATD_SSTORE(smem);
  __syncthreads();
  float pe[32];
  {
    if (1 < nst) ATD_GLOAD(1);
    const char* sb = smem;
    f32x16 S0, S1;
#pragma unroll
    for (int q = 0; q < 16; ++q) { S0[q] = 0.f; S1[q] = 0.f; }
#pragma unroll
    for (int ks = 0; ks < KS; ++ks) {
      const bf16x8 k0 = *(const bf16x8*)(sb + koff + ks * 32);
      const bf16x8 k1 = *(const bf16x8*)(sb + koff + 32 * KSTR + ks * 32);
      S0 = MFMA(k0, qf[ks], S0); S1 = MFMA(k1, qf[ks], S1);
    }
    float mx = S0[0];
#pragma unroll
    for (int q = 1; q < 16; ++q) mx = fmaxf(mx, S0[q]);
#pragma unroll
    for (int q = 0; q < 16; ++q) mx = fmaxf(mx, S1[q]);
    mx = fmaxf(mx, __shfl_xor(mx, 32));
    const float mnew = fmaxf(m, mx);
    l *= ex2(m - mnew);
    m = mnew;
#pragma unroll
    for (int q = 0; q < 16; ++q) { pe[q] = ex2(S0[q] - mnew); pe[16 + q] = ex2(S1[q] - mnew); }
    if (1 < nst) ATD_SSTORE(smem + STAGE);
    __syncthreads();
  }
  int cur = 1, prv = 0;
#pragma unroll 1
  for (int i = 1; i < nst; ++i) {
    if (i + 1 < nst) ATD_GLOAD(i + 1);
    const char* sb = smem + cur * STAGE;
    const char* sp = smem + prv * STAGE;
    f32x16 S0, S1;
    {
      const float nm = -m;
#pragma unroll
      for (int q = 0; q < 16; ++q) { S0[q] = nm; S1[q] = nm; }
    }
    f2_t racc = {0.f, 0.f};
    u32 pw[16];
    bf16x8 kfr[2];
    kfr[0] = *(const bf16x8*)(sb + koff);
    kfr[1] = *(const bf16x8*)(sb + koff + 32 * KSTR);
#pragma unroll
    for (int g = 0; g < NA; ++g) {
      const bf16x8 kf = kfr[g & 1];
      if (g + 2 < NA) kfr[g & 1] = *(const bf16x8*)(sb + koff + ((g + 2) & 1) * 32 * KSTR + ((g + 2) >> 1) * 32);
      if (g & 1) S1 = MFMA(kf, qf[g >> 1], S1); else S0 = MFMA(kf, qf[g >> 1], S0);
#pragma unroll
      for (int pp = (g * 16) / NA; pp < ((g + 1) * 16) / NA; ++pp) {
        const f2_t e2 = {pe[2 * pp], pe[2 * pp + 1]};
        racc += e2;
        pw[pp] = pk2(pe[2 * pp], pe[2 * pp + 1]);
        ATT_PIN(pw[pp]);
      }
      ATT_PIN(racc);
      __builtin_amdgcn_sched_barrier(0);
    }
    l += racc.x + racc.y;
    bf16x8 pf[4];
#pragma unroll
    for (int s = 0; s < 4; ++s) {
      const uint4 pq = make_uint4(pw[4 * s], pw[4 * s + 1], pw[4 * s + 2], pw[4 * s + 3]);
      pf[s] = __builtin_bit_cast(bf16x8, pq);
    }
    if (MODE != 0 && i >= 8) {
      const int pos0 = win_pos0 + (i - 8) * 64;
      if (MODE == 1) {
        const int keyrow = (pos0 - 512) >> 6;
        const bool rowok = (keyrow >= r0) && (keyrow < r0 + 8);
        const int c0 = min(max(c - 8, 0), 48);
#pragma unroll
        for (int q = 0; q < 32; ++q) {
          const int keycol = 32 * (q >> 4) + 16 * ((q >> 3) & 1) + 8 * hh + (q & 7);
          const bool valid = rowok && ((unsigned)(keycol - c0) < 16u);
          int bi = (keyrow - r + 7) * 31 + (keycol - c + 15);
          bi = min(max(bi, 0), 464);
          const float bv = sbias[bi];
          if (q < 16) S0[q & 15] = valid ? S0[q & 15] + bv : -1e30f; else S1[q & 15] = valid ? S1[q & 15] + bv : -1e30f;
        }
      } else {
        const int t0 = pos0 - 512, tq = tq0 + n;
#pragma unroll
        for (int q = 0; q < 32; ++q) {
          const int d = t0 + 32 * (q >> 4) + 16 * ((q >> 3) & 1) + 8 * hh + (q & 7) - tq;
          const bool valid = (d >= -128) && (d <= 128);
          if (q < 16) S0[q & 15] = valid ? S0[q & 15] : -1e30f; else S1[q & 15] = valid ? S1[q & 15] : -1e30f;
        }
      }
    }
    float mx = S0[0];
#pragma unroll
    for (int q = 1; q < 16; ++q) mx = fmaxf(mx, S0[q]);
#pragma unroll
    for (int q = 0; q < 16; ++q) mx = fmaxf(mx, S1[q]);
    mx = fmaxf(mx, __shfl_xor(mx, 32));
    const bool moved = __any(mx > 8.f);
    __builtin_amdgcn_sched_barrier(0);
#define ATD_PHASEB(SUB_) do { \
    bf16x8 vfr[2]; \
    vfr[0] = *(const bf16x8*)(sp + voff); \
    vfr[1] = *(const bf16x8*)(sp + voff + ((1 / MT) >> 1) * DV * 80 + (1 % MT) * 32 * 80 + ((1 / MT) & 1) * 32); \
    _Pragma("unroll") for (int j = 0; j < NB; ++j) { \
      const bf16x8 vf = vfr[j & 1]; \
      if (j + 2 < NB) { const int s2 = (j + 2) / MT, m2 = (j + 2) % MT; \
        vfr[j & 1] = *(const bf16x8*)(sp + voff + ((s2 >> 1) * DV + m2 * 32) * 80 + (s2 & 1) * 32); } \
      O[j % MT] = MFMA(vf, pf[j / MT], O[j % MT]); \
      _Pragma("unroll") for (int q = (j * 32) / NB; q < ((j + 1) * 32) / NB; ++q) { \
        pe[q] = ex2(q < 16 ? S0[q & 15] : S1[q & 15]); \
        ATT_PIN(pe[q]); } \
      __builtin_amdgcn_sched_barrier(0); } } while (0)
    float alpha = 1.f;
    if (moved) {
      const float dmx = fmaxf(mx, 0.f);
      alpha = ex2(-dmx);
      m += dmx;
      l *= alpha;
#pragma unroll
      for (int q = 0; q < 16; ++q) { S0[q] -= dmx; S1[q] -= dmx; }
    }
    ATD_PHASEB(+ 0.f);
#undef ATD_PHASEB
    if (moved) {
#pragma unroll
      for (int mt = 0; mt < MT; ++mt)
#pragma unroll
        for (int q = 0; q < 16; ++q) O[mt][q] *= alpha;
    }
    const int nxt = (cur == 2) ? 0 : cur + 1;
    if (i + 1 < nst) ATD_SSTORE(smem + nxt * STAGE);
    prv = cur; cur = nxt;
    __syncthreads();
  }
  {
    const char* sp = smem + prv * STAGE;
    float rs = 0.f;
#pragma unroll
    for (int q = 0; q < 32; ++q) rs += pe[q];
    l += rs;
#pragma unroll
    for (int s = 0; s < 4; ++s) {
      const uint4 pq = make_uint4(pk2(pe[8 * s], pe[8 * s + 1]), pk2(pe[8 * s + 2], pe[8 * s + 3]), pk2(pe[8 * s + 4], pe[8 * s + 5]), pk2(pe[8 * s + 6], pe[8 * s + 7]));
      const bf16x8 pfs = __builtin_bit_cast(bf16x8, pq);
#pragma unroll
      for (int mt = 0; mt < MT; ++mt) {
        const bf16x8 vf = *(const bf16x8*)(sp + voff + ((s >> 1) * DV + mt * 32) * 80 + (s & 1) * 32);
        O[mt] = MFMA(vf, pfs, O[mt]);
      }
    }
  }
#undef ATD_GLOAD
#undef ATD_SSTORE
  const float inv = 1.f / (l + __shfl_xor(l, 32));
  if (EPI == 0) {
#pragma unroll
    for (int mt = 0; mt < MT; ++mt)
#pragma unroll
      for (int g = 0; g < 4; ++g) {
        uint2 o;
        o.x = pk2(O[mt][4 * g] * inv, O[mt][4 * g + 1] * inv);
        o.y = pk2(O[mt][4 * g + 2] * inv, O[mt][4 * g + 3] * inv);
        *(uint2*)(op + mt * 32 + 8 * g + 4 * hh) = o;
      }
  } else if (EPI == 1) {
#pragma unroll
    for (int mt = 0; mt < MT; ++mt)
#pragma unroll
      for (int q = 0; q < 8; ++q) park[(mt * 8 + q) * 64 + lane] = pk2(O[mt][2 * q] * inv, O[mt][2 * q + 1] * inv);
  } else {
    float ss = 0.f;
    const float li = lam * inv;
#pragma unroll
    for (int mt = 0; mt < MT; ++mt) {
#pragma unroll
      for (int q = 0; q < 8; ++q) {
        const u32 pwd = park[(mt * 8 + q) * 64 + lane];
        const float v0 = bf2f((u16)(pwd & 0xffff)) - li * O[mt][2 * q];
        const float v1 = bf2f((u16)(pwd >> 16)) - li * O[mt][2 * q + 1];
        O[mt][2 * q] = v0; O[mt][2 * q + 1] = v1; ss += v0 * v0 + v1 * v1;
      }
      asm volatile("" ::: "memory");
    }
    ss += __shfl_xor(ss, 32);
    const float rn = rsqrtf(ss * (1.f / (MT * 32)) + 1e-5f) * 0.8f;
#pragma unroll
    for (int mt = 0; mt < MT; ++mt)
#pragma unroll
      for (int g = 0; g < 4; ++g) {
        const float4 sg = *(const float4*)(subln + mt * 32 + 8 * g + 4 * hh);
        uint2 o;
        o.x = pk2(O[mt][4 * g] * rn * sg.x, O[mt][4 * g + 1] * rn * sg.y);
        o.y = pk2(O[mt][4 * g + 2] * rn * sg.z, O[mt][4 * g + 3] * rn * sg.w);
        *(uint2*)(op + mt * 32 + 8 * g + 4 * hh) = o;
      }
  }
}

template <int LAYER>
DI void attn_phase(const Params& p, char* smem) {
  constexpr int NH = (LAYER == 0) ? 8 : 16;
  constexpr int nlat = 8 * NH * 16, nctx = 32 * NH;
  const int w = ltid() >> 6, lane = ltid() & 63, n = lane & 31, hh = lane >> 5;
  const u16* Q = (const u16*)(p.ws + WS_R + R_Q);
  const u16* Kb = (const u16*)(p.ws + WS_R + R_K);
  const u16* Vt = (const u16*)(p.ws + WS_R + R_VT);
  const u16* KPE = (const u16*)(p.ws + WS_R + R_KPE);
  u16* Ob = (u16*)(p.ws + WS_H);
  float lam = 0.f;
  if (LAYER == 0) {
    const float* lp = p.in[19];
    float a = lp[lane] * lp[64 + lane], b = lp[128 + lane] * lp[192 + lane];
#pragma unroll
    for (int o = 32; o > 0; o >>= 1) { a += __shfl_xor(a, o); b += __shfl_xor(b, o); }
    lam = expf(a) - expf(b) + 0.2f;
  }
  float* sbias = (float*)(smem + ATT_PARK);
  u32* park = (u32*)(smem + ATT_PARK) + w * 2048;
#pragma unroll 1
  for (int item0 = blockIdx.x; item0 < nlat + nctx; item0 += gridDim.x) {
    const bool lat = item0 < nlat;
    int item = item0;
    if (lat && gridDim.x == 256) {
      const int xcd = blockIdx.x & 7, slot = blockIdx.x >> 3;
      item = (((item0 >> 8) * 16 + xcd * 2 + (slot >> 4)) << 4) + (slot & 15);
    }
    int b, h, qb;
    if (lat) { qb = item & 15; h = (item >> 4) % NH; b = (item >> 4) / NH; }
    else { const int it2 = item - nlat; qb = 0; h = it2 % NH; b = it2 / NH; }
    const int q0 = qb * 256;
    const int tq0 = q0 + w * 32;
    const int row = lat ? NCTX + b * 4096 + tq0 + n : b * 256 + tq0 + n;
    const int krow0 = lat ? NCTX + b * LATS : b * 256;
    const int nst_dense = lat ? 72 : 4;
    if (LAYER == 0) {
      const u16* vp = Vt + (lat ? (size_t)NCTX * 1024 : 0) + (size_t)((b * 8 + h) * (lat ? 144 : 8)) * (128 * 32);
      attn_block_dense<4, 4, false, 1>(smem, Q + (size_t)row * 1024 + h * 128, Kb + (size_t)krow0 * 1024 + h * 128, 1024, nullptr, vp,
                                       Ob + (size_t)row * 1024 + h * 128, nst_dense, -1e30f, 0.f, lam, p.in[20], park);
      attn_block_dense<4, 4, false, 2>(smem, Q + (size_t)row * 1024 + h * 128 + 64, Kb + (size_t)krow0 * 1024 + h * 128 + 64, 1024, nullptr, vp,
                                       Ob + (size_t)row * 1024 + h * 128, nst_dense, -1e30f, 0.f, lam, p.in[20], park);
    } else if (LAYER == 1) {
      const u16* vp = Vt + (lat ? (size_t)NCTX * 1024 : 0) + (size_t)((b * 16 + h) * (lat ? 144 : 8)) * (64 * 32);
      if (lat) {
        __syncthreads();
        for (int i = ltid(); i < 465; i += 512) sbias[i] = p.in[23][h * 465 + i] * LOG2E;
        const int r = qb * 4 + (w >> 1), c = (w & 1) * 32 + n;
        const int r0 = min(max(r - 4, 0), 56);
        const int gr_lo = min(max(qb * 4 - 4, 0), 56), gr_hi = min(max(qb * 4 + 3 - 4, 0), 56) + 8;
        attn_block_dense<4, 2, false, 0, 1>(smem, Q + (size_t)row * 1024 + h * 64, Kb + (size_t)krow0 * 1024 + h * 64, 1024, nullptr, vp,
                                            Ob + (size_t)row * 1024 + h * 64, 8 + gr_hi - gr_lo, -1e30f, 0.f, 0.f, nullptr, nullptr,
                                            512 + gr_lo * 64, r, r0, c, sbias, tq0);
      } else {
        attn_block_dense<4, 2, false, 0>(smem, Q + (size_t)row * 1024 + h * 64, Kb + (size_t)krow0 * 1024 + h * 64, 1024, nullptr, vp,
                                         Ob + (size_t)row * 1024 + h * 64, 4, -1e30f, 0.f, 0.f, nullptr, nullptr);
      }
    } else if (LAYER == 2) {
      const u16* vp = Vt + (lat ? (size_t)NCTX * 1024 : 0) + (size_t)((b * 16 + h) * (lat ? 144 : 8)) * (64 * 32);
      attn_block_dense<6, 2, true, 0>(smem, Q + (size_t)row * 1536 + h * 96, Kb + (size_t)krow0 * 1024 + h * 64, 1024, KPE + (size_t)krow0 * 32, vp,
                                      Ob + (size_t)row * 1024 + h * 64, nst_dense, -1e30f, 0.f, 0.f, nullptr, nullptr);
    } else {
      const int hk = h >> 2;
      const u16* vp = Vt + (lat ? (size_t)NCTX * 256 : 0) + (size_t)((b * 4 + hk) * (lat ? 144 : 8)) * (64 * 32);
      const float sk = p.in[32][h] * LOG2E;
      const float li = hh == 0 ? 1.f : 0.f;
      if (lat) {
        const int j_lo = q0 == 0 ? 2 : 0;
        const int j_hi = min(10, (4096 + 128 - q0) >> 6);
        attn_block_dense<4, 2, false, 0, 2>(smem, Q + (size_t)row * 1024 + h * 64, Kb + (size_t)krow0 * 256 + hk * 64, 256, nullptr, vp,
                                            Ob + (size_t)row * 1024 + h * 64, 8 + j_hi - j_lo, sk, li, 0.f, nullptr, nullptr,
                                            512 + q0 - 128 + 64 * j_lo, 0, 0, 0, nullptr, tq0);
      } else {
        attn_block_dense<4, 2, false, 0>(smem, Q + (size_t)row * 1024 + h * 64, Kb + (size_t)krow0 * 256 + hk * 64, 256, nullptr, vp,
                                         Ob + (size_t)row * 1024 + h * 64, 4, sk, li, 0.f, nullptr, nullptr);
      }
    }
  }
}

#define XB_TMO      128
#define XB_XCNT(j)  (256  + 64 * (j))
#define XB_XSUB(j)  (1280 + 64 * (j))
#define XB_XGEN(j)  (2304 + 64 * (j))
#define XB_TOP      3328
#define XB_TOPGEN   3392
#define XCD_BAR_WORDS 3456
#define XB_SPIN_CAP (1u << 18)
DI unsigned xb_ld(unsigned* p) { return __hip_atomic_load(p, __ATOMIC_RELAXED, __HIP_MEMORY_SCOPE_AGENT); }
DI unsigned xb_add(unsigned* p, unsigned v) { return __hip_atomic_fetch_add(p, v, __ATOMIC_RELAXED, __HIP_MEMORY_SCOPE_AGENT); }
DI unsigned xb_xcc_id() { return (unsigned)__builtin_amdgcn_s_getreg((3 << 11) | 20) & 0xFu; }
#define XB_SPIN(cond, bar) do { unsigned _sp = 0; while (cond) { __builtin_amdgcn_s_sleep(1); \
    if ((++_sp & 255u) == 0u) { if (xb_ld(&(bar)[XB_TMO])) break; if (_sp > XB_SPIN_CAP) { atomicAdd(&(bar)[XB_TMO], 1u); break; } } } } while (0)
struct XcdBarrier { unsigned* bar; unsigned x; volatile PG8_LAS unsigned* st; };
DI XcdBarrier xcd_barrier_post(unsigned* bar, volatile PG8_LAS unsigned* st) {
  XcdBarrier b; b.bar = bar; b.x = xb_xcc_id(); b.st = st;
  if (threadIdx.x == 0) (void)xb_add(&bar[XB_XCNT(b.x)], 1u);
  return b;
}
DI void xcd_barrier_complete(unsigned* bar, unsigned x, unsigned& nloc, unsigned& nx) {
  const unsigned G = gridDim.x * gridDim.y * gridDim.z;
  unsigned sum, cnt, mine, sp = 0u;
  for (;;) {
    sum = 0u; cnt = 0u; mine = 0u;
#pragma unroll
    for (unsigned j = 0; j < 16; ++j) { const unsigned c = xb_ld(&bar[XB_XCNT(j)]); sum += c; cnt += (c > 0u) ? 1u : 0u; mine = (j == x) ? c : mine; }
    if (sum == G) break;
    __builtin_amdgcn_s_sleep(1);
    if ((++sp & 255u) == 0u) { if (xb_ld(&bar[XB_TMO])) break; if (sp > XB_SPIN_CAP) { atomicAdd(&bar[XB_TMO], 1u); break; } }
  }
  nloc = mine > 0u ? mine : 1u; nx = cnt > 0u ? cnt : 1u;
}
DI void xcd_barrier(const XcdBarrier& b) {
  asm volatile("s_waitcnt vmcnt(0)" ::: "memory");
  __syncthreads();
  if (threadIdx.x == 0) {
    unsigned* bar = b.bar;
    __builtin_amdgcn_s_waitcnt(0);
    unsigned nloc = b.st[0], nx = b.st[1];
    if (nloc == 0u) { xcd_barrier_complete(bar, b.x, nloc, nx); b.st[0] = nloc; b.st[1] = nx; }
    const unsigned old = xb_add(&bar[XB_XSUB(b.x)], 1u);
    const unsigned gen = old / nloc;
    if (old + 1u == (gen + 1u) * nloc) {
      __builtin_amdgcn_fence(__ATOMIC_RELEASE, "agent");
      asm volatile("s_waitcnt vmcnt(0)" ::: "memory");
      const unsigned og = xb_add(&bar[XB_TOP], 1u);
      const unsigned tg = og / nx;
      if (og + 1u == (tg + 1u) * nx) xb_add(&bar[XB_TOPGEN], 1u);
      else XB_SPIN(xb_ld(&bar[XB_TOPGEN]) == tg, bar);
      __builtin_amdgcn_fence(__ATOMIC_ACQUIRE, "agent");
      xb_add(&bar[XB_XGEN(b.x)], 1u);
      asm volatile("s_waitcnt vmcnt(0)" ::: "memory");
    } else {
      XB_SPIN(xb_ld(&bar[XB_XGEN(b.x)]) == gen, bar);
      __builtin_amdgcn_fence(__ATOMIC_ACQUIRE, "agent");
      asm volatile("s_waitcnt vmcnt(0)" ::: "memory");
    }
  }
  __syncthreads();
}

DI void setup_gemm(const Params& p, int layer, int sub, Sched2& S, Epi2& E) {
  u16* wt = (u16*)(p.ws + WS_W);
  u16* H = (u16*)(p.ws + WS_H);
  char* R = p.ws + WS_R;
  GJ j = gj_base(p);
  const u16* act = H; const u16* w = wt; int M = NTOK, K = 1024, N0 = 1024, NV = 0;
  if (sub == 0) {
    if (layer == 0) {
      j.n_k0 = 1024;
      j.oq = (u16*)(R + R_Q); j.ldq = 1024; j.qrope = 1; j.qscale = 0.125f * LOG2E;
      j.ok = (u16*)(R + R_K); j.ldk = 1024; j.krope = 1; j.kst = p.out + O_K0; j.ldkst = 1024;
      j.ovt = (u16*)(R + R_VT); j.HV = 8; j.dvshift = 7; j.vst = p.out + O_V0; j.ldvst = 1024;
      w = wt + W_L0QKV; N0 = 2048; NV = 1024;
    } else if (layer == 1) {
      j.n_k0 = 1024;
      j.oq = (u16*)(R + R_Q); j.ldq = 1024; j.qrope = 0; j.qscale = 0.125f * LOG2E;
      j.ok = (u16*)(R + R_K); j.ldk = 1024; j.krope = 0; j.kst = p.out + O_K1; j.ldkst = 1024;
      j.ovt = (u16*)(R + R_VT); j.HV = 16; j.dvshift = 6; j.vst = p.out + O_V1; j.ldvst = 1024;
      w = wt + W_L1QKV; N0 = 2048; NV = 1024;
    } else if (layer == 2) {
      j.nvalid = 800; j.oq = (u16*)R; j.ldq = 800;
      w = wt + W_L2A; N0 = 1024; NV = 0;
    } else {
      j.n_k0 = 1024;
      j.oq = (u16*)(R + R_Q); j.ldq = 1024; j.qrope = 1; j.qscale = 0.125f * LOG2E;
      j.ok = (u16*)(R + R_K); j.ldk = 256; j.krope = 1; j.kst = p.out + O_K3; j.ldkst = 256;
      j.ovt = (u16*)(R + R_VT); j.HV = 4; j.dvshift = 6; j.vst = p.out + O_V3; j.ldvst = 256;
      w = wt + W_L3QKV; N0 = 1280; NV = 256;
    }
  } else if (sub == 2) {
    j.oq = (u16*)(R + R_Q); j.ldq = 1536; j.qrope = 2; j.qscale = 0.10206207261596577f * LOG2E;
    w = wt + W_L2UQ; K = 512; N0 = 1536;
  } else if (sub == 3) {
    j.n_k0 = 0; j.kspace = 1;
    j.ok = (u16*)(R + R_K); j.ldk = 1024; j.krope = 0;
    j.ovt = (u16*)(R + R_VT); j.HV = 16; j.dvshift = 6;
    act = H + (size_t)NTOK * 512; w = wt + W_L2UKV; M = NKROW; K = 256; N0 = 1024; NV = 1024;
  } else if (sub == 5) {
    const size_t wo = layer == 0 ? W_L0O : layer == 1 ? W_L1O : layer == 2 ? W_L2O : W_L3O;
    j.oq = (u16*)(R + R_Q); j.ldq = 1024; j.simple = 1;
    w = wt + wo;
  } else if (sub == 7) {
    j.oq = (u16*)R; j.ldq = 4096; j.relu2 = 1; j.simple = 1;
    w = wt + W_MLP1 + (size_t)layer * 4 * Mi; N0 = 4096;
  } else {
    j.oq = H; j.ldq = 1024; j.simple = 1;
    act = (const u16*)R; w = wt + W_MLP2 + (size_t)layer * 4 * Mi; K = 4096;
  }
  S.act = (const char*)act; S.w = (const char*)w; S.K = K; S.tstep = (size_t)256 * K * 2; S.w1off = (size_t)N0 * K * 2;
  S.nM0 = M / 256; S.nN0 = N0 / 256; S.nM1 = NV / 256; S.n0 = S.nM0 * S.nN0; S.n1 = S.nM1 * S.nM0; S.G = gridDim.x; S.c = blockIdx.x;
  E.j = j;
}

__global__ void __launch_bounds__(512, 2) mega(Params p) {
  cg::grid_group grid = cg::this_grid();
  __shared__ __attribute__((aligned(16))) char smem[155648];
  char* R = p.ws + WS_R;
  u16* H = (u16*)(p.ws + WS_H);
  const float* mods = (const float*)(p.ws + WS_MODS);
  __shared__ uint4 xb_words;
  if (threadIdx.x == 0) xb_words = make_uint4(0u, 0u, 0u, 0u);
  __syncthreads();
  const XcdBarrier xb = xcd_barrier_post((unsigned*)(p.ws + WS_BAR), (volatile PG8_LAS unsigned*)&xb_words);
  prepass(p, smem);
  xcd_barrier(xb);
  if (p.ws == nullptr) grid.sync();
  h0_pass(p);
  xcd_barrier(xb);
#pragma unroll 1
  for (int step = 0; step < 40; ++step) {
    const int layer = step / 10, sub = step - layer * 10;
    if (sub == 3 || (layer != 2 && (sub == 1 || sub == 2))) continue;
    if (sub == 0 && layer != 2) {
      const float* ck = layer == 0 ? p.in[2] : layer == 1 ? p.in[4] : p.in[8];
      const float* cv = layer == 0 ? p.in[3] : layer == 1 ? p.in[5] : p.in[9];
      cache_convert(p, ck, cv, (u16*)(R + R_K), (u16*)(R + R_VT), layer == 3 ? 256 : 1024, layer == 0 ? 8 : layer == 1 ? 16 : 4, layer == 0 ? 128 : 64);
    }
    if (sub == 0 || sub == 2 || sub == 3 || sub == 5 || sub == 7 || sub == 8) {
      const int njobs = (sub == 2) ? 2 : 1;
#pragma unroll 1
      for (int jb = 0; jb < njobs; ++jb) {
        Sched2 S; Epi2 E;
        setup_gemm(p, layer, sub + jb, S, E);
        gemm_phase((PG8_LAS unsigned char*)smem, S, E);
      }
    } else if (sub == 1) {
      mla_norm_pass(p);
    } else if (sub == 4) {
      if (layer == 0) attn_phase<0>(p, smem);
      else if (layer == 1) attn_phase<1>(p, smem);
      else if (layer == 2) attn_phase<2>(p, smem);
      else attn_phase<3>(p, smem);
    } else {
      const float* ml = mods + (size_t)layer * 9 * 6144;
      if (sub == 6) {
        const float* xc = layer == 0 ? p.in[0] : p.out;
        const float* xl = layer == 0 ? p.in[1] : p.out + (size_t)NCTX * DM;
        ln_pass(p, (const u16*)(R + R_Q), ml + 2 * 1024, p.in[14] + (size_t)(layer * 2) * 1024, p.in[15] + (size_t)(layer * 2) * 1024, ml + 3 * 1024);
      } else {
        const float* mn = layer < 3 ? mods + (size_t)(layer + 1) * 9 * 6144 : nullptr;
        ln_pass(p, H, ml + 5 * 1024, p.in[14] + (size_t)(layer * 2 + 1) * 1024, p.in[15] + (size_t)(layer * 2 + 1) * 1024, mn);
      }
    }
    xcd_barrier(xb);
  }
}

extern "C" void kernel_launch(void* const* d_in, const int* in_sizes, int n_in, void* d_out, int out_size, void* d_ws,
                              size_t ws_size, hipStream_t stream) {
  static int grid_blocks = 0;
  if (!grid_blocks) {
    int dev = 0, cus = 0, per_cu = 0;
    hipGetDevice(&dev);
    hipDeviceGetAttribute(&cus, hipDeviceAttributeMultiprocessorCount, dev);
    hipOccupancyMaxActiveBlocksPerMultiprocessor(&per_cu, mega, 512, 0);
    if (per_cu > 1) per_cu = 1;
    grid_blocks = cus * per_cu;
  }
  if (ws_size < WS_TOTAL) fprintf(stderr, "workspace too small: %zu < %zu\n", ws_size, (size_t)WS_TOTAL);
  Params p{};
  for (int i = 0; i < 34; ++i) p.in[i] = (const float*)d_in[i];
  p.out = (float*)d_out;
  p.ws = (char*)d_ws;
  (void)hipMemsetAsync((char*)d_ws + WS_BAR, 0, XCD_BAR_WORDS * 4, stream);
  void* args[] = {&p};
  hipError_t e = hipLaunchCooperativeKernel((void*)mega, dim3(grid_blocks), dim3(512), args, 0, stream);
  if (e != hipSuccess) fprintf(stderr, "cooperative launch failed: %s (grid %d)\n", hipGetErrorString(e), grid_blocks);
}
```

```cpp
#include <hip/hip_runtime.h>
#include <hip/hip_cooperative_groups.h>
#include <cstdio>
namespace cg = cooperative_groups;

typedef unsigned short u16;
typedef unsigned int u32;
using bf16x8 = __attribute__((ext_vector_type(8))) short;
using f32x16 = __attribute__((ext_vector_type(16))) float;
typedef __bf16 bf2_t __attribute__((ext_vector_type(2)));
typedef float f2_t __attribute__((ext_vector_type(2)));
typedef float f4_t __attribute__((ext_vector_type(4)));
#define DI __device__ __forceinline__
#define MFMA(a, b, c) __builtin_amdgcn_mfma_f32_32x32x16_bf16((a), (b), (c), 0, 0, 0)

DI u32 pk2(float a, float b) { f2_t v = {a, b}; bf2_t r = __builtin_convertvector(v, bf2_t); return __builtin_bit_cast(u32, r); }
DI float bf2f(u16 x) { return __uint_as_float(((u32)x) << 16); }
DI float ex2(float x) { return __builtin_amdgcn_exp2f(x); }
typedef unsigned u2nt_t __attribute__((ext_vector_type(2)));
DI uint2 nt_load2(const u16* p) { const u2nt_t v = __builtin_nontemporal_load((const u2nt_t*)p); return make_uint2(v.x, v.y); }
DI void nt_store2(u16* p, uint2 v) { u2nt_t w = {v.x, v.y}; __builtin_nontemporal_store(w, (u2nt_t*)p); }
DI float4 nt_load4(const float* p) { const f4_t v = __builtin_nontemporal_load((const f4_t*)p); return make_float4(v.x, v.y, v.z, v.w); }
DI void nt_store4(float* p, float4 v) { f4_t w = {v.x, v.y, v.z, v.w}; __builtin_nontemporal_store(w, (f4_t*)p); }
DI int ltid() { int t = threadIdx.x; asm volatile("" : "+v"(t)); return t; }

constexpr int NCTX = 8192, NLAT = 32768, NTOK = 40960, NKROW = 45056, DM = 1024, LATS = 4608;
constexpr size_t MiB = 1u << 20;
constexpr size_t Mi = 1u << 20;
constexpr size_t WS_R = 0, WS_H = 320 * MiB, WS_W = 400 * MiB, WS_MODS = 492 * MiB, WS_ROPE = 493 * MiB, WS_BAR = 493 * MiB + 65536, WS_TOTAL = 494 * MiB;
constexpr size_t R_Q = 0, R_K = 120 * MiB, R_VT = 208 * MiB, R_KPE = 296 * MiB;
constexpr size_t W_MLP1 = 0, W_MLP2 = 16 * Mi;
constexpr size_t W_L0QKV = 32 * Mi, W_L0O = 35 * Mi, W_L1QKV = 36 * Mi, W_L1O = 39 * Mi;
constexpr size_t W_L2A = 40 * Mi;
constexpr size_t W_L2UQ = W_L2A + 1024 * 1024;
constexpr size_t W_L2UKV = W_L2UQ + 1536 * 512;
constexpr size_t W_L2O = W_L2UKV + 2048 * 256;
constexpr size_t W_L3QKV = W_L2O + Mi;
constexpr size_t W_L3O = W_L3QKV + 1536 * 1024;
constexpr size_t O_K0 = 41943040, O_V0 = 50331648, O_K1 = 58720256, O_V1 = 67108864, O_CKV2 = 75497472,
                 O_KPE2 = 77594624, O_K3 = 77856768, O_V3 = 79953920;
constexpr float LOG2E = 1.4426950408889634f;
constexpr float ALPHA = 1.681792830507429f;

struct Params {
  const float* in[34];
  float* out;
  char* ws;
};

constexpr int TLD = 72;
DI void transpose_weight(const float* __restrict__ W, u16* __restrict__ Wt, int K, int N, int Npad, int perm, char* smem) {
  u16* sm = (u16*)smem;
  const int tid = ltid();
  const int nkt = K >> 6, nnt = Npad >> 6;
  for (int tile = blockIdx.x; tile < nkt * nnt; tile += gridDim.x) {
    const int kt = tile % nkt, nt = tile / nkt;
    const int k0 = kt << 6, n0 = nt << 6;
#pragma unroll
    for (int i = 0; i < 2; ++i) {
      const int idx = tid + 512 * i;
      const int kr = idx >> 4, c4 = idx & 15;
      float4 v = make_float4(0.f, 0.f, 0.f, 0.f);
      if (n0 + c4 * 4 < N) v = *(const float4*)(W + (size_t)(k0 + kr) * N + n0 + c4 * 4);
      const u32 a = pk2(v.x, v.y), b = pk2(v.z, v.w);
      sm[(c4 * 4 + 0) * TLD + kr] = (u16)(a & 0xffff);
      sm[(c4 * 4 + 1) * TLD + kr] = (u16)(a >> 16);
      sm[(c4 * 4 + 2) * TLD + kr] = (u16)(b & 0xffff);
      sm[(c4 * 4 + 3) * TLD + kr] = (u16)(b >> 16);
    }
    __syncthreads();
    {
      const int idx = tid;
      const int nl = idx >> 3, kc = idx & 7;
      int nn = n0 + nl;
      if (perm) nn = ((nn & 127) < 64) ? ((nn >> 7) * 64 + (nn & 63)) : (1024 + (nn >> 7) * 64 + ((nn & 127) - 64));
      *(uint4*)(Wt + (size_t)nn * K + k0 + kc * 8) = *(const uint4*)(sm + nl * TLD + kc * 8);
    }
    __syncthreads();
  }
}

DI void mods_item(const Params& p, int item, char* smem) {
  float* ssilu = (float*)smem;
  float* sred = ssilu + 9216;
  const int tid = ltid();
  const int l = item / 96, n0 = (item % 96) * 64;
  const float* cctx = p.in[11];
  const float* cv = p.in[10];
  for (int i = tid; i < 9216; i += 512) {
    const int r = i >> 10, k = i & 1023;
    const float c = (r == 0) ? cctx[k] : cv[(r - 1) * 1024 + k];
    ssilu[i] = c / (1.f + expf(-c));
  }
  __syncthreads();
  const int kg = tid >> 4, cl = tid & 15;
  float acc[9][4];
#pragma unroll
  for (int r = 0; r < 9; ++r) { acc[r][0] = 0.f; acc[r][1] = 0.f; acc[r][2] = 0.f; acc[r][3] = 0.f; }
  const float* W = p.in[12] + (size_t)l * 1024 * 6144 + n0 + cl * 4;
  for (int kk = 0; kk < 32; ++kk) {
    const int k = kg * 32 + kk;
    const float4 w4 = *(const float4*)(W + (size_t)k * 6144);
#pragma unroll
    for (int r = 0; r < 9; ++r) {
      const float s = ssilu[r * 1024 + k];
      acc[r][0] += s * w4.x; acc[r][1] += s * w4.y; acc[r][2] += s * w4.z; acc[r][3] += s * w4.w;
    }
  }
#pragma unroll
  for (int r = 0; r < 9; ++r)
    *(float4*)(sred + (kg * 9 + r) * 64 + cl * 4) = make_float4(acc[r][0], acc[r][1], acc[r][2], acc[r][3]);
  __syncthreads();
  float* mods = (float*)(p.ws + WS_MODS);
  for (int o = tid; o < 576; o += 512) {
    const int r = o >> 6, nn = o & 63;
    float s = p.in[13][l * 6144 + n0 + nn];
#pragma unroll
    for (int g = 0; g < 32; ++g) s += sred[(g * 9 + r) * 64 + nn];
    mods[(size_t)(l * 9 + r) * 6144 + n0 + nn] = s;
  }
  __syncthreads();
}

DI void prepass(const Params& p, char* smem) {
  u16* wt = (u16*)(p.ws + WS_W);
  for (int item = blockIdx.x; item < 384; item += gridDim.x) mods_item(p, item, smem);
  if (blockIdx.x == gridDim.x - 1) {
    float* t16 = (float*)(p.ws + WS_ROPE);
    float* t8 = t16 + 64 * 16 * 2;
    for (int i = ltid(); i < 1024; i += 512) {
      const int pos = i >> 4, j = i & 15;
      const float inv = powf(10000.f, -(float)j / 16.f);
      float s, c; sincosf((float)pos * inv, &s, &c);
      t16[2 * i] = c; t16[2 * i + 1] = s;
    }
    for (int i = ltid(); i < 512; i += 512) {
      const int pos = i >> 3, j = i & 7;
      const float inv = powf(10000.f, -(float)j / 8.f);
      float s, c; sincosf((float)pos * inv, &s, &c);
      t8[2 * i] = c; t8[2 * i + 1] = s;
    }
  }
#pragma unroll 1
  for (int l = 0; l < 4; ++l) {
    transpose_weight(p.in[16] + (size_t)l * 1024 * 4096, wt + W_MLP1 + (size_t)l * 4 * Mi, 1024, 4096, 4096, 0, smem);
    transpose_weight(p.in[17] + (size_t)l * 4096 * 1024, wt + W_MLP2 + (size_t)l * 4 * Mi, 4096, 1024, 1024, 0, smem);
  }
  transpose_weight(p.in[18], wt + W_L0QKV, 1024, 3072, 3072, 0, smem);
  transpose_weight(p.in[21], wt + W_L0O, 1024, 1024, 1024, 0, smem);
  transpose_weight(p.in[22], wt + W_L1QKV, 1024, 3072, 3072, 0, smem);
  transpose_weight(p.in[24], wt + W_L1O, 1024, 1024, 1024, 0, smem);
  transpose_weight(p.in[25], wt + W_L2A, 1024, 800, 1024, 0, smem);
  transpose_weight(p.in[28], wt + W_L2UQ, 512, 1536, 1536, 0, smem);
  transpose_weight(p.in[29], wt + W_L2UKV, 256, 2048, 2048, 1, smem);
  transpose_weight(p.in[30], wt + W_L2O, 1024, 1024, 1024, 0, smem);
  transpose_weight(p.in[31], wt + W_L3QKV, 1024, 1536, 1536, 0, smem);
  transpose_weight(p.in[33], wt + W_L3O, 1024, 1024, 1024, 0, smem);
}

DI int cond_of_row(int row) { return row < NCTX ? 0 : 1 + ((row - NCTX) >> 12); }

DI void h0_pass(const Params& p) {
  const int lane = ltid() & 63;
  const int wid = blockIdx.x * 8 + (ltid() >> 6), nw = gridDim.x * 8;
  const float* mods = (const float*)(p.ws + WS_MODS);
  u16* H = (u16*)(p.ws + WS_H);
  const int rpw = (NTOK + nw - 1) / nw;
  const int r0 = wid * rpw, r1 = min(r0 + rpw, NTOK);
  if (r0 >= r1) return;
  float4 sh[4], sc[4], xv[4];
  int cur_cond = -1;
  {
    const float* x = r0 < NCTX ? p.in[0] + (size_t)r0 * DM : p.in[1] + (size_t)(r0 - NCTX) * DM;
#pragma unroll
    for (int j = 0; j < 4; ++j) { xv[j] = nt_load4(x + j * 256 + lane * 4); sh[j] = make_float4(0.f, 0.f, 0.f, 0.f); sc[j] = sh[j]; }
  }
#pragma unroll 1
  for (int row = r0; row < r1; ++row) {
    const int cnd = cond_of_row(row);
    if (cnd != cur_cond) {
      cur_cond = cnd;
      const float* md = mods + (size_t)cnd * 6144;
#pragma unroll
      for (int j = 0; j < 4; ++j) { sh[j] = *(const float4*)(md + j * 256 + lane * 4); sc[j] = *(const float4*)(md + 1024 + j * 256 + lane * 4); }
    }
    float4 nx[4];
    const int rn = (row + 1 < r1) ? row + 1 : row;
    {
      const float* x = rn < NCTX ? p.in[0] + (size_t)rn * DM : p.in[1] + (size_t)(rn - NCTX) * DM;
#pragma unroll
      for (int j = 0; j < 4; ++j) nx[j] = nt_load4(x + j * 256 + lane * 4);
    }
#pragma unroll
    for (int j = 0; j < 4; ++j) {
      uint2 o;
      o.x = pk2(xv[j].x * (1.f + sc[j].x) + sh[j].x, xv[j].y * (1.f + sc[j].y) + sh[j].y);
      o.y = pk2(xv[j].z * (1.f + sc[j].z) + sh[j].z, xv[j].w * (1.f + sc[j].w) + sh[j].w);
      *(uint2*)(H + (size_t)row * DM + j * 256 + lane * 4) = o;
      uint2 xb; xb.x = pk2(xv[j].x, xv[j].y); xb.y = pk2(xv[j].z, xv[j].w);
      nt_store2((u16*)(p.out + (size_t)row * DM) + j * 256 + lane * 4, xb);
    }
#pragma unroll
    for (int j = 0; j < 4; ++j) xv[j] = nx[j];
  }
}

DI void ln_pass(const Params& p, const u16* y, const float* mods_gate,
                const float* g, const float* bta, const float* mods_next  ) {
  const int lane = ltid() & 63;
  const int wid = blockIdx.x * 8 + (ltid() >> 6), nw = gridDim.x * 8;
  u16* H = (u16*)(p.ws + WS_H);
  const int rpw = (NTOK + nw - 1) / nw;
  const int r0 = wid * rpw, r1 = min(r0 + rpw, NTOK);
  if (r0 >= r1) return;
  float4 gg[4], bb[4], gt[4], sh[4], sc[4];
#pragma unroll
  for (int j = 0; j < 4; ++j) {
    gg[j] = *(const float4*)(g + j * 256 + lane * 4);
    bb[j] = *(const float4*)(bta + j * 256 + lane * 4);
    gt[j] = make_float4(0.f, 0.f, 0.f, 0.f); sh[j] = gt[j]; sc[j] = gt[j];
  }
  int cur_cond = -1;
  auto load_row = [&](int rr, uint2 (&xr)[4], uint2 (&yr)[4]) {
#pragma unroll
    for (int j = 0; j < 4; ++j) {
      xr[j] = nt_load2((const u16*)(p.out + (size_t)rr * DM) + j * 256 + lane * 4);
      yr[j] = nt_load2(y + (size_t)rr * DM + j * 256 + lane * 4);
    }
  };
  auto process = [&](int row, const uint2 (&xv)[4], const uint2 (&yv)[4]) {
    const int cnd = cond_of_row(row);
    if (cnd != cur_cond) {
      cur_cond = cnd;
#pragma unroll
      for (int j = 0; j < 4; ++j) {
        gt[j] = *(const float4*)(mods_gate + (size_t)cnd * 6144 + j * 256 + lane * 4);
        if (mods_next) {
          sh[j] = *(const float4*)(mods_next + (size_t)cnd * 6144 + j * 256 + lane * 4);
          sc[j] = *(const float4*)(mods_next + (size_t)cnd * 6144 + 1024 + j * 256 + lane * 4);
        }
      }
    }
    float v[16];
    float sum = 0.f;
#pragma unroll
    for (int j = 0; j < 4; ++j) {
      v[4 * j + 0] = ALPHA * bf2f((u16)(xv[j].x & 0xffff)) + gt[j].x * bf2f((u16)(yv[j].x & 0xffff));
      v[4 * j + 1] = ALPHA * bf2f((u16)(xv[j].x >> 16)) + gt[j].y * bf2f((u16)(yv[j].x >> 16));
      v[4 * j + 2] = ALPHA * bf2f((u16)(xv[j].y & 0xffff)) + gt[j].z * bf2f((u16)(yv[j].y & 0xffff));
      v[4 * j + 3] = ALPHA * bf2f((u16)(xv[j].y >> 16)) + gt[j].w * bf2f((u16)(yv[j].y >> 16));
      sum += v[4 * j] + v[4 * j + 1] + v[4 * j + 2] + v[4 * j + 3];
    }
#pragma unroll
    for (int o = 32; o > 0; o >>= 1) sum += __shfl_xor(sum, o);
    const float mu = sum * (1.f / 1024.f);
    float sq = 0.f;
#pragma unroll
    for (int i = 0; i < 16; ++i) { const float d = v[i] - mu; sq += d * d; }
#pragma unroll
    for (int o = 32; o > 0; o >>= 1) sq += __shfl_xor(sq, o);
    const float rs = rsqrtf(sq * (1.f / 1024.f) + 1e-5f);
    float* xo = p.out + (size_t)row * DM;
#pragma unroll
    for (int j = 0; j < 4; ++j) {
      const int c = j * 256 + lane * 4;
      float4 xn;
      xn.x = (v[4 * j + 0] - mu) * rs * gg[j].x + bb[j].x;
      xn.y = (v[4 * j + 1] - mu) * rs * gg[j].y + bb[j].y;
      xn.z = (v[4 * j + 2] - mu) * rs * gg[j].z + bb[j].z;
      xn.w = (v[4 * j + 3] - mu) * rs * gg[j].w + bb[j].w;
      if (mods_next) {
        uint2 xb; xb.x = pk2(xn.x, xn.y); xb.y = pk2(xn.z, xn.w);
        nt_store2((u16*)xo + c, xb);
        uint2 o;
        o.x = pk2(xn.x * (1.f + sc[j].x) + sh[j].x, xn.y * (1.f + sc[j].y) + sh[j].y);
        o.y = pk2(xn.z * (1.f + sc[j].z) + sh[j].z, xn.w * (1.f + sc[j].w) + sh[j].w);
        *(uint2*)(H + (size_t)row * DM + c) = o;
      } else {
        nt_store4(xo + c, xn);
      }
    }
  };
  uint2 xa[4], ya[4], xb2[4], yb2[4];
  load_row(r0, xa, ya);
  load_row(min(r0 + 1, r1 - 1), xb2, yb2);
#pragma unroll 1
  for (int row = r0; row < r1; row += 2) {
    uint2 nxa[4], nya[4], nxb[4], nyb[4];
    load_row(min(row + 2, r1 - 1), nxa, nya);
    load_row(min(row + 3, r1 - 1), nxb, nyb);
    process(row, xa, ya);
    if (row + 1 < r1) process(row + 1, xb2, yb2);
#pragma unroll
    for (int j = 0; j < 4; ++j) { xa[j] = nxa[j]; ya[j] = nya[j]; xb2[j] = nxb[j]; yb2[j] = nyb[j]; }
  }
}

DI void mla_norm_pass(const Params& p) {
  const int lane = ltid() & 63;
  const int wid = blockIdx.x * 8 + (ltid() >> 6), nw = gridDim.x * 8;
  const u16* araw = (const u16*)(p.ws + WS_R);
  u16* cqn = (u16*)(p.ws + WS_H);
  u16* ckvn = cqn + (size_t)NTOK * 512;
  u16* kpeb = (u16*)(p.ws + WS_R + R_KPE);
  const float* qn = p.in[26];
  const float* kvn = p.in[27];
  const float* t8 = (const float*)(p.ws + WS_ROPE) + 64 * 16 * 2;
  {
    const int rpw = (NTOK + nw - 1) / nw;
    const int r0 = wid * rpw, r1 = min(r0 + rpw, NTOK);
    const float4 g0 = *(const float4*)(qn + lane * 8);
    const float4 g1 = *(const float4*)(qn + lane * 8 + 4);
    const float4 gk = *(const float4*)(kvn + lane * 4);
    float4 c0 = make_float4(0.f, 0.f, 0.f, 0.f), c1 = c0, k4 = c0; float kp = 0.f;
#define MLA_UNPK(w_, lo_, hi_) do { lo_ = bf2f((u16)((w_) & 0xffff)); hi_ = bf2f((u16)((w_) >> 16)); } while (0)
    if (r0 < r1) {
      const u16* a = araw + (size_t)r0 * 800;
      const uint4 q8 = *(const uint4*)(a + lane * 8); const uint2 q4 = *(const uint2*)(a + 512 + lane * 4);
      MLA_UNPK(q8.x, c0.x, c0.y); MLA_UNPK(q8.y, c0.z, c0.w); MLA_UNPK(q8.z, c1.x, c1.y); MLA_UNPK(q8.w, c1.z, c1.w);
      MLA_UNPK(q4.x, k4.x, k4.y); MLA_UNPK(q4.y, k4.z, k4.w);
      kp = bf2f(a[768 + (lane & 31)]);
    }
#pragma unroll 1
    for (int row = r0; row < r1; ++row) {
      const int rn = (row + 1 < r1) ? row + 1 : row;
      const u16* an = araw + (size_t)rn * 800;
      const uint4 nq8 = *(const uint4*)(an + lane * 8); const uint2 nq4 = *(const uint2*)(an + 512 + lane * 4);
      const u16 nkpw = an[768 + (lane & 31)];
      const bool is_lat = row >= NCTX;
      int krow, t = 0;
      if (is_lat) { const int r2 = row - NCTX; const int b = r2 >> 12; t = r2 & 4095; krow = NCTX + b * LATS + 512 + t; }
      else krow = row;
      float ss = c0.x * c0.x + c0.y * c0.y + c0.z * c0.z + c0.w * c0.w + c1.x * c1.x + c1.y * c1.y + c1.z * c1.z + c1.w * c1.w;
#pragma unroll
      for (int o = 32; o > 0; o >>= 1) ss += __shfl_xor(ss, o);
      float rs = rsqrtf(ss * (1.f / 512.f) + 1e-5f);
      uint4 o;
      o.x = pk2(c0.x * rs * g0.x, c0.y * rs * g0.y); o.y = pk2(c0.z * rs * g0.z, c0.w * rs * g0.w);
      o.z = pk2(c1.x * rs * g1.x, c1.y * rs * g1.y); o.w = pk2(c1.z * rs * g1.z, c1.w * rs * g1.w);
      *(uint4*)(cqn + (size_t)row * 512 + lane * 8) = o;
      float s2 = k4.x * k4.x + k4.y * k4.y + k4.z * k4.z + k4.w * k4.w;
#pragma unroll
      for (int o2 = 32; o2 > 0; o2 >>= 1) s2 += __shfl_xor(s2, o2);
      rs = rsqrtf(s2 * (1.f / 256.f) + 1e-5f);
      float4 kn4;
      kn4.x = k4.x * rs * gk.x; kn4.y = k4.y * rs * gk.y; kn4.z = k4.z * rs * gk.z; kn4.w = k4.w * rs * gk.w;
      uint2 ok2; ok2.x = pk2(kn4.x, kn4.y); ok2.y = pk2(kn4.z, kn4.w);
      *(uint2*)(ckvn + (size_t)krow * 256 + lane * 4) = ok2;
      if (!is_lat) *(float4*)(p.out + O_CKV2 + (size_t)row * 256 + lane * 4) = kn4;
      const int half = (lane >> 3) & 1, jj = lane & 7;
      const float x1 = __shfl(kp, half * 16 + jj), x2 = __shfl(kp, half * 16 + 8 + jj);
      const float nbv = __shfl_xor(kp, 1);
      if (!is_lat) {
        if (lane < 32) {
          p.out[O_KPE2 + (size_t)row * 32 + lane] = kp;
          if ((lane & 1) == 0) *(u32*)(kpeb + (size_t)krow * 32 + lane) = pk2(kp, nbv);
        }
      } else {
        const int pos = half ? (t & 63) : (t >> 6);
        const float cs = t8[(pos * 8 + jj) * 2], sn = t8[(pos * 8 + jj) * 2 + 1];
        const float o1 = x1 * cs - x2 * sn, o2 = x2 * cs + x1 * sn;
        const float n1 = __shfl_xor(o1, 1), n2 = __shfl_xor(o2, 1);
        if (lane < 16 && (lane & 1) == 0) {
          *(u32*)(kpeb + (size_t)krow * 32 + half * 16 + jj) = pk2(o1, n1);
          *(u32*)(kpeb + (size_t)krow * 32 + half * 16 + 8 + jj) = pk2(o2, n2);
        }
      }
      MLA_UNPK(nq8.x, c0.x, c0.y); MLA_UNPK(nq8.y, c0.z, c0.w); MLA_UNPK(nq8.z, c1.x, c1.y); MLA_UNPK(nq8.w, c1.z, c1.w);
      MLA_UNPK(nq4.x, k4.x, k4.y); MLA_UNPK(nq4.y, k4.z, k4.w);
      kp = bf2f(nkpw);
    }
  }
  for (int cr = wid; cr < 4096; cr += nw) {
    const int b = cr >> 9, s = cr & 511;
    const int krow = NCTX + b * LATS + s;
    const float4 k4 = *(const float4*)(p.in[6] + (size_t)cr * 256 + lane * 4);
    uint2 ok2; ok2.x = pk2(k4.x, k4.y); ok2.y = pk2(k4.z, k4.w);
    *(uint2*)(ckvn + (size_t)krow * 256 + lane * 4) = ok2;
    if (lane < 16) {
      const float2 e = *(const float2*)(p.in[7] + (size_t)cr * 32 + lane * 2);
      *(u32*)(kpeb + (size_t)krow * 32 + lane * 2) = pk2(e.x, e.y);
    }
  }
}

DI void cache_convert(const Params& p, const float* ck, const float* cvv, u16* kbuf, u16* vt, int C, int HV, int DV) {
  const int gt = blockIdx.x * 512 + ltid(), ng = gridDim.x * 512;
  const int per_row4 = C >> 2;
  const int total4 = 8 * 512 * per_row4;
  for (int i0 = gt; i0 < total4; i0 += 4 * ng) {
    float4 v[4];
#pragma unroll
    for (int u = 0; u < 4; ++u) { const int i = i0 + u * ng; v[u] = make_float4(0.f, 0.f, 0.f, 0.f); if (i < total4) v[u] = *(const float4*)(ck + (size_t)i * 4); }
#pragma unroll
    for (int u = 0; u < 4; ++u) {
      const int i = i0 + u * ng;
      if (i < total4) {
        const int cr = i / per_row4, c4 = i - cr * per_row4;
        const int b = cr >> 9, s = cr & 511;
        uint2 o; o.x = pk2(v[u].x, v[u].y); o.y = pk2(v[u].z, v[u].w);
        *(uint2*)(kbuf + (size_t)(NCTX + b * LATS + s) * C + c4 * 4) = o;
      }
    }
  }
  const int CV = HV * DV;
  const int totalv = 8 * 16 * 8 * CV;
  u16* vlat = vt + (size_t)NCTX * CV;
  for (int i0 = gt; i0 < totalv; i0 += 4 * ng) {
    float a[4][4];
#pragma unroll
    for (int u = 0; u < 4; ++u) {
      const int i = i0 + u * ng;
      a[u][0] = a[u][1] = a[u][2] = a[u][3] = 0.f;
      if (i < totalv) {
        const int col = i % CV; int r = i / CV;
        const int kq = r & 7; r >>= 3;
        const int tile = r & 15; const int b = r >> 4;
        const float* src = cvv + ((size_t)(b * 512 + tile * 32 + kq * 4)) * CV + col;
        a[u][0] = src[0]; a[u][1] = src[CV]; a[u][2] = src[2 * (size_t)CV]; a[u][3] = src[3 * (size_t)CV];
      }
    }
#pragma unroll
    for (int u = 0; u < 4; ++u) {
      const int i = i0 + u * ng;
      if (i < totalv) {
        const int col = i % CV; int r = i / CV;
        const int kq = r & 7; r >>= 3;
        const int tile = r & 15; const int b = r >> 4;
        const int hv = col / DV, dv = col - hv * DV;
        uint2 o; o.x = pk2(a[u][0], a[u][1]); o.y = pk2(a[u][2], a[u][3]);
        *(uint2*)(vlat + ((size_t)((b * HV + hv) * 144 + tile) * DV + dv) * 32 + kq * 4) = o;
      }
    }
  }
}


#define PG8_LAS __attribute__((address_space(3)))
typedef float f32x4 __attribute__((ext_vector_type(4)));
constexpr int BM = 256, BK = 64, HALF = 128, HTB = HALF * BK * 2, STAGE_BYTES = 8 * HTB, NXCD = 8, WGM = 8;
DI int lds_byte(int r, int c) { const int st = (r >> 4) * 2 + (c >> 5), rr = r & 15, cc = c & 31, ob = rr * 64 + cc * 2; return st * 1024 + (ob ^ (((ob >> 9) & 1) << 5)); }
DI void stage_rc(int b, int& R, int& C) { const int st = b / 1024, sb = b % 1024, swz = sb ^ (((sb >> 9) & 1) << 5); R = (st >> 1) * 16 + swz / 64; C = (st & 1) * 32 + (swz % 64) / 2; }
DI int perm32(int rho) { const int n = rho >> 4, i = rho & 15; return 8 * (i >> 2) + 4 * n + (i & 3); }

struct Unit { int pm, pn, kind; };
struct Sched2 {
  const char* act; const char* w; size_t tstep, w1off;
  int K, nM0, nN0, nM1, n0, n1, G, c;
  int rev;
  DI void map(int wgid, int nM, int nN, int& pm, int& pn) const {
    const int nwg = nM * nN;
    { const int q = nwg / NXCD, r = nwg % NXCD, xcd = wgid % NXCD, off = wgid / NXCD; wgid = (xcd < r ? xcd * (q + 1) : r * (q + 1) + (xcd - r) * q) + off; }
    const int nig = WGM * nN, gid = wgid / nig, fm = gid * WGM, gsz = (nM - fm) < WGM ? (nM - fm) : WGM;
    pm = fm + ((wgid % nig) % gsz); pn = (wgid % nig) / gsz;
  }
  DI bool next(int i, Unit& u) const {
    int L = i * G + c;
    if (L < n0) { map(L, nM0, nN0, u.pm, u.pn); if (rev) u.pm = nM0 - 1 - u.pm; u.kind = 0; return true; }
    L -= n0;
    if (L < n1) { map(L, nM1, nM0, u.pm, u.pn); u.kind = 1; return true; }
    return false;
  }
  DI const char* abase(const Unit& u) const { return u.kind == 0 ? act + (size_t)u.pm * tstep : w + w1off + (size_t)u.pm * tstep; }
  DI const char* bbase(const Unit& u) const { return u.kind == 0 ? w + (size_t)u.pn * tstep : act + (size_t)u.pn * tstep; }
};

DI void rope64p(float (&v)[8], int parity, int t, int fq, const float* t16) {
  const int pos = parity ? (t & 63) : (t >> 6);
  const float* tb = t16 + (pos * 16 + 8 * (fq & 1)) * 2;
#pragma unroll
  for (int q4 = 0; q4 < 4; ++q4) {
    const float4 cs = *(const float4*)(tb + q4 * 4);
    const float p0 = __shfl_xor(v[2 * q4], 32), p1 = __shfl_xor(v[2 * q4 + 1], 32);
    if (fq < 2) { v[2 * q4] = v[2 * q4] * cs.x - p0 * cs.y; v[2 * q4 + 1] = v[2 * q4 + 1] * cs.z - p1 * cs.w; }
    else { v[2 * q4] = v[2 * q4] * cs.x + p0 * cs.y; v[2 * q4 + 1] = v[2 * q4 + 1] * cs.z + p1 * cs.w; }
  }
}
DI void rope32p(float (&v)[8], int t, int fq, const float* t8) {
  const int pos = (fq < 2) ? (t >> 6) : (t & 63);
  const float* tb = t8 + (pos * 8) * 2;
#pragma unroll
  for (int q4 = 0; q4 < 4; ++q4) {
    const float4 cs = *(const float4*)(tb + q4 * 4);
    const float p0 = __shfl_xor(v[2 * q4], 16), p1 = __shfl_xor(v[2 * q4 + 1], 16);
    if ((fq & 1) == 0) { v[2 * q4] = v[2 * q4] * cs.x - p0 * cs.y; v[2 * q4 + 1] = v[2 * q4 + 1] * cs.z - p1 * cs.w; }
    else { v[2 * q4] = v[2 * q4] * cs.x + p0 * cs.y; v[2 * q4 + 1] = v[2 * q4 + 1] * cs.z + p1 * cs.w; }
  }
}

struct GJ {
  int nvalid, n_k0, kspace;
  u16* oq; int ldq; int qrope; float qscale; int relu2; float* of32; int ldf32;
  int simple;
  u16* ok; int ldk; int krope; float* kst; int ldkst;
  u16* ovt; int HV; int dvshift; float* vst; int ldvst;
  const float* t16; const float* t8;
};

struct Epi2 {
  static constexpr bool PERM = true;
  GJ j;
  DI void operator()(const f32x4 (&acc)[2][2][4][2], const Unit& u, int wr, int wc, int fr_, int fq_) const {
    int ln = fr_ + 16 * fq_;
    asm volatile("" : "+v"(ln));
    const int fr = ln & 15, fq = ln >> 4;
    if (j.simple) {
      typedef unsigned u32x4_t __attribute__((ext_vector_type(4)));
      u16* const ob = j.oq + (size_t)(u.pm * 256 + wr * 64 + fr) * j.ldq + u.pn * 256 + wc * 32 + fq * 8;
#pragma unroll
      for (int ai = 0; ai < 2; ++ai)
#pragma unroll
        for (int m = 0; m < 4; ++m)
#pragma unroll
          for (int bj = 0; bj < 2; ++bj) {
            float v[8];
#pragma unroll
            for (int jj = 0; jj < 4; ++jj) { v[jj] = acc[ai][bj][m][0][jj]; v[4 + jj] = acc[ai][bj][m][1][jj]; }
            if (j.relu2) {
#pragma unroll
              for (int i = 0; i < 8; ++i) { const float r = fmaxf(v[i], 0.f); v[i] = r * r; }
            }
            const u32x4_t o = {pk2(v[0], v[1]), pk2(v[2], v[3]), pk2(v[4], v[5]), pk2(v[6], v[7])};
            u32x4_t* dst = (u32x4_t*)(ob + (size_t)(ai * 128 + m * 16) * j.ldq + bj * 128);
            *dst = o;
          }
      return;
    }
    if (u.kind == 0) {
      const bool is_lat = (u.pm * 256 >= NCTX);
      const bool qtype = (u.pn * 256 < j.n_k0);
      const bool rope_q = is_lat && (j.qrope == 1), rope_q2 = is_lat && (j.qrope == 2), rope_k = is_lat && (j.krope != 0);
      const bool kstate = (j.kst != nullptr) && !is_lat;
#pragma unroll
      for (int ai = 0; ai < 2; ++ai)
#pragma unroll
        for (int m = 0; m < 4; ++m) {
          const int row = u.pm * 256 + ai * 128 + wr * 64 + m * 16 + fr;
          int t = 0, krow = row;
          if (!j.kspace && is_lat) { const int r2 = row - NCTX; const int b = r2 >> 12; t = r2 & 4095; krow = NCTX + b * LATS + 512 + t; }
#pragma unroll
          for (int bj = 0; bj < 2; ++bj) {
            const int c8 = u.pn * 256 + bj * 128 + wc * 32 + fq * 8;
            float v[8];
#pragma unroll
            for (int jj = 0; jj < 4; ++jj) { v[jj] = acc[ai][bj][m][0][jj]; v[4 + jj] = acc[ai][bj][m][1][jj]; }
            if (qtype) {
              if (rope_q) rope64p(v, (c8 >> 5) & 1, t, fq, j.t16);
              if (rope_q2 && (((u.pn * 8 + bj * 4 + wc) % 3) == 2)) rope32p(v, t, fq, j.t8);
              if (j.of32) {
                if (c8 < j.nvalid) {
                  *(float4*)(j.of32 + (size_t)row * j.ldf32 + c8) = make_float4(v[0], v[1], v[2], v[3]);
                  *(float4*)(j.of32 + (size_t)row * j.ldf32 + c8 + 4) = make_float4(v[4], v[5], v[6], v[7]);
                }
              } else {
                const float qs = j.qscale;
                uint4 o; o.x = pk2(v[0] * qs, v[1] * qs); o.y = pk2(v[2] * qs, v[3] * qs); o.z = pk2(v[4] * qs, v[5] * qs); o.w = pk2(v[6] * qs, v[7] * qs);
                if (c8 < j.nvalid) *(uint4*)(j.oq + (size_t)row * j.ldq + c8) = o;
              }
            } else {
              const int fk = c8 - j.n_k0;
              if (kstate) {
                *(float4*)(j.kst + (size_t)row * j.ldkst + fk) = make_float4(v[0], v[1], v[2], v[3]);
                *(float4*)(j.kst + (size_t)row * j.ldkst + fk + 4) = make_float4(v[4], v[5], v[6], v[7]);
              }
              if (rope_k) rope64p(v, (c8 >> 5) & 1, t, fq, j.t16);
              uint4 o; o.x = pk2(v[0], v[1]); o.y = pk2(v[2], v[3]); o.z = pk2(v[4], v[5]); o.w = pk2(v[6], v[7]);
              *(uint4*)(j.ok + (size_t)krow * j.ldk + fk) = o;
            }
            asm volatile("" ::: "memory");
          }
        }
    } else {
      const int DV = 1 << j.dvshift;
      const int tok0 = u.pn * 256;
      const bool is_lat = tok0 >= NCTX;
      int bb, s0, nt; size_t sbase;
      if (is_lat) {
        const int r2 = tok0 - NCTX;
        if (j.kspace) { bb = r2 / LATS; s0 = r2 - bb * LATS; } else { bb = r2 >> 12; s0 = 512 + (r2 & 4095); }
        nt = 144; sbase = (size_t)NCTX * j.HV * DV;
      } else { bb = tok0 >> 8; s0 = 0; nt = 8; sbase = 0; }
      const bool vstate = (j.vst != nullptr) && !is_lat;
#pragma unroll
      for (int ai = 0; ai < 2; ++ai)
#pragma unroll
        for (int m = 0; m < 4; ++m) {
          const int f = u.pm * 256 + ai * 128 + wr * 64 + m * 16 + fr;
          const int hv = f >> j.dvshift, dv = f & (DV - 1);
          u16* const vrow = j.ovt + sbase + ((size_t)((bb * j.HV + hv) * nt) * DV + dv) * 32;
#pragma unroll
          for (int bj = 0; bj < 2; ++bj) {
            const int tl = bj * 128 + wc * 32 + fq * 8;
            const int s = s0 + tl;
            uint4 o;
            o.x = pk2(acc[ai][bj][m][0][0], acc[ai][bj][m][0][1]); o.y = pk2(acc[ai][bj][m][0][2], acc[ai][bj][m][0][3]);
            o.z = pk2(acc[ai][bj][m][1][0], acc[ai][bj][m][1][1]); o.w = pk2(acc[ai][bj][m][1][2], acc[ai][bj][m][1][3]);
            *(uint4*)(vrow + (size_t)(s >> 5) * DV * 32 + (s & 31)) = o;
            if (vstate) {
#pragma unroll
              for (int n2 = 0; n2 < 2; ++n2)
#pragma unroll
                for (int jj = 0; jj < 4; ++jj) j.vst[(size_t)(tok0 + tl + 4 * n2 + jj) * j.ldvst + f] = acc[ai][bj][m][n2][jj];
            }
            asm volatile("" ::: "memory");
          }
        }
    }
  }
};

DI void gemm_phase(PG8_LAS unsigned char* lds, const Sched2& S, const Epi2& E) {
  const int tid = ltid(), wid = __builtin_amdgcn_readfirstlane(tid >> 6), lane = tid & 63, wr = wid >> 2, wc = wid & 3, fr = lane & 15, fq = lane >> 4;
  const int K = S.K, nt = K / BK;
  unsigned voffA[2], voffB[2];
#pragma unroll
  for (int i = 0; i < 2; ++i) { int R, C; stage_rc(tid * 16 + i * 8192, R, C); const int Rb = (R & ~31) + perm32(R & 31);
    voffA[i] = (unsigned)(R * K + C) * 2u; voffB[i] = (unsigned)(Rb * K + C) * 2u; }
  const size_t kstep = (size_t)(BK * 2);
  const size_t hstep = (size_t)HALF * K * 2;
  const unsigned ldsw = (unsigned)wid * 1024u;
  const int aoff = lds_byte(wr * 64 + fr, fq * 8), boff = lds_byte(wc * 32 + fr, fq * 8);
#define PG8_SA(b, h) (((b) * 2 + (h)) * HTB)
#define PG8_SB(b, h) ((4 + (b) * 2 + (h)) * HTB)
#define PG8_STAGE(bufoff, gbase, voff) do { _Pragma("unroll") for (int _i = 0; _i < 2; ++_i) \
        __builtin_amdgcn_global_load_lds((const unsigned*)((const char*)(gbase) + (voff)[_i]), (PG8_LAS unsigned*)(lds + (bufoff) + ldsw + _i * 8192), 16, 0, 0); } while (0)
#define PG8_LDA(dst, b, h) do { _Pragma("unroll") for (int m = 0; m < 4; ++m) _Pragma("unroll") for (int k = 0; k < 2; ++k) dst[m][k] = *(const PG8_LAS bf16x8*)(lds + PG8_SA(b, h) + aoff + m * 2048 + k * 1024); } while (0)
#define PG8_LDB(dst, b, h) do { _Pragma("unroll") for (int n = 0; n < 2; ++n) _Pragma("unroll") for (int k = 0; k < 2; ++k) dst[n][k] = *(const PG8_LAS bf16x8*)(lds + PG8_SB(b, h) + boff + n * 2048 + k * 1024); } while (0)
#define PG8_MMA(ai, bj, At, Bt) do { __builtin_amdgcn_s_setprio(1); _Pragma("unroll") for (int m = 0; m < 4; ++m) _Pragma("unroll") for (int n = 0; n < 2; ++n) _Pragma("unroll") for (int k = 0; k < 2; ++k) \
        acc[ai][bj][m][n] = __builtin_amdgcn_mfma_f32_16x16x32_bf16(Bt[n][k], At[m][k], acc[ai][bj][m][n], 0, 0, 0); __builtin_amdgcn_s_setprio(0); } while (0)
#define PG8_WAIT_V(n) asm volatile("s_waitcnt vmcnt(" #n ")" ::: "memory")
#define PG8_WAIT_L(n) asm volatile("s_waitcnt lgkmcnt(" #n ")" ::: "memory")
#define PG8_BAR __builtin_amdgcn_s_barrier()
#define PG8_SCHED __builtin_amdgcn_sched_barrier(0)
  Unit cur, nxt; int ui = 0;
  if (!S.next(0, cur)) return;
  f32x4 acc[2][2][4][2];
#pragma unroll
  for (int a = 0; a < 2; ++a)
#pragma unroll
    for (int b = 0; b < 2; ++b)
#pragma unroll
      for (int m = 0; m < 4; ++m)
#pragma unroll
        for (int n = 0; n < 2; ++n) acc[a][b][m][n] = (f32x4){0.f, 0.f, 0.f, 0.f};
  bf16x8 At[4][2], B0[2][2], B1[2][2];
  const char* cA = S.abase(cur); const char* cB = S.bbase(cur);
  PG8_STAGE(PG8_SB(0, 0), cB, voffB); PG8_STAGE(PG8_SA(0, 0), cA, voffA); PG8_STAGE(PG8_SB(0, 1), cB + hstep, voffB); PG8_STAGE(PG8_SA(0, 1), cA + hstep, voffA);
  if (wr == 1) PG8_BAR;
  PG8_WAIT_V(4); PG8_BAR;
  PG8_STAGE(PG8_SB(1, 0), cB + kstep, voffB); PG8_STAGE(PG8_SA(1, 0), cA + kstep, voffA); PG8_STAGE(PG8_SB(1, 1), cB + hstep + kstep, voffB);
  PG8_WAIT_V(6); PG8_BAR;
  for (;;) {
    const bool has_next = S.next(ui + 1, nxt);
    const char* nA = has_next ? S.abase(nxt) : cA; const char* nB = has_next ? S.bbase(nxt) : cB;
    for (int t = 0; t < nt; t += 2) {
      const bool last = (t == nt - 2);
      const char* a1 = cA + (size_t)(t + 1) * kstep;
      const char* a2 = last ? nA : cA + (size_t)(t + 2) * kstep; const char* b2 = last ? nB : cB + (size_t)(t + 2) * kstep;
      const char* a3 = a2 + kstep; const char* b3 = b2 + kstep;
      PG8_LDB(B0, 0, 0); PG8_SCHED; PG8_LDA(At, 0, 0); PG8_STAGE(PG8_SA(1, 1), a1 + hstep, voffA);
      PG8_WAIT_L(8); PG8_BAR; PG8_WAIT_L(0); PG8_MMA(0, 0, At, B0); PG8_BAR; PG8_SCHED;
      PG8_LDB(B1, 0, 1); PG8_STAGE(PG8_SB(0, 0), b2, voffB);
      PG8_BAR; PG8_WAIT_L(0); PG8_MMA(0, 1, At, B1); PG8_BAR;
      PG8_LDA(At, 0, 1); PG8_STAGE(PG8_SA(0, 0), a2, voffA);
      PG8_BAR; PG8_WAIT_L(0); PG8_MMA(1, 0, At, B0); PG8_BAR; PG8_SCHED;
      PG8_STAGE(PG8_SB(0, 1), b2 + hstep, voffB);
      PG8_WAIT_V(6); PG8_BAR; PG8_MMA(1, 1, At, B1); PG8_BAR;
      PG8_LDB(B0, 1, 0); PG8_SCHED; PG8_LDA(At, 1, 0); PG8_STAGE(PG8_SA(0, 1), a2 + hstep, voffA);
      PG8_WAIT_L(8); PG8_BAR; PG8_WAIT_L(0); PG8_MMA(0, 0, At, B0); PG8_BAR; PG8_SCHED;
      PG8_LDB(B1, 1, 1); PG8_STAGE(PG8_SB(1, 0), b3, voffB);
      PG8_BAR; PG8_WAIT_L(0); PG8_MMA(0, 1, At, B1); PG8_BAR;
      PG8_LDA(At, 1, 1); PG8_STAGE(PG8_SA(1, 0), a3, voffA);
      PG8_BAR; PG8_WAIT_L(0); PG8_MMA(1, 0, At, B0); PG8_BAR; PG8_SCHED;
      PG8_STAGE(PG8_SB(1, 1), b3 + hstep, voffB);
      PG8_WAIT_V(6); PG8_BAR; PG8_MMA(1, 1, At, B1); PG8_BAR;
    }
    E(acc, cur, wr, wc, fr, fq);
    if (!has_next) break;
#pragma unroll
    for (int a = 0; a < 2; ++a)
#pragma unroll
      for (int b = 0; b < 2; ++b)
#pragma unroll
        for (int m = 0; m < 4; ++m)
#pragma unroll
          for (int n = 0; n < 2; ++n) acc[a][b][m][n] = (f32x4){0.f, 0.f, 0.f, 0.f};
    cur = nxt; cA = nA; cB = nB; ++ui;
  }
  PG8_WAIT_V(0);
  if (wr == 0) PG8_BAR;
  PG8_BAR;
#undef PG8_SA
#undef PG8_SB
#undef PG8_STAGE
#undef PG8_LDA
#undef PG8_LDB
#undef PG8_MMA
#undef PG8_WAIT_V
#undef PG8_WAIT_L
#undef PG8_BAR
#undef PG8_SCHED
}

DI GJ gj_base(const Params& p) {
  GJ j;
  j.nvalid = 1 << 30; j.n_k0 = 1 << 30; j.kspace = 0;
  j.oq = nullptr; j.ldq = 1024; j.qrope = 0; j.qscale = 1.f; j.relu2 = 0; j.of32 = nullptr; j.ldf32 = 0; j.simple = 0;
  j.ok = nullptr; j.ldk = 1024; j.krope = 0; j.kst = nullptr; j.ldkst = 0;
  j.ovt = nullptr; j.HV = 16; j.dvshift = 6; j.vst = nullptr; j.ldvst = 0;
  j.t16 = (const float*)(p.ws + WS_ROPE); j.t8 = j.t16 + 64 * 16 * 2;
  return j;
}
constexpr int ATT_PARK = 90112;
template <int KS, int MT, int MODE, bool MLA, int EPI>
DI void attn_block(char* smem, const u16* __restrict__ qp, const u16* __restrict__ kp, int ldk, const u16* __restrict__ kpe,
                   const u16* __restrict__ vp, u16* __restrict__ op, int nst, int win_pos0, float m_init, float l_init,
                   int r, int r0, int c, const float* sbias, int tq0, float lam, const float* subln, u32* park) {
  constexpr int DV = MT * 32;
  constexpr int KSTR = KS * 32 + 16;
  constexpr int VOFF = 64 * KSTR;
  constexpr int STAGE = VOFF + 2 * DV * 80;
  constexpr int NVC = (2 * DV * 4) / 512;
  const int tid = ltid(), lane = tid & 63, n = lane & 31, hh = lane >> 5;
  const int kperm = (n & 16) + 8 * ((n >> 2) & 1) + 4 * ((n >> 3) & 1) + (n & 3);
  bf16x8 qf[KS];
#pragma unroll
  for (int ks = 0; ks < KS; ++ks) qf[ks] = *(const bf16x8*)(qp + ks * 16 + hh * 8);
  f32x16 O[MT];
  float m = m_init, l = l_init;
#pragma unroll
  for (int mt = 0; mt < MT; ++mt)
#pragma unroll
    for (int i = 0; i < 16; ++i) O[mt][i] = 0.f;
  const int c0 = min(max(c - 8, 0), 48);
  const int tq = tq0 + n;
  const int krow_l = tid >> 3, kpart = tid & 7;
  const int perow = tid >> 2, pepart = tid & 3;
  const int vsub0 = tid / (DV * 4), vrem0 = tid - vsub0 * (DV * 4);
  const int vsrc0 = vsub0 * (DV * 32) + (vrem0 >> 2) * 32 + (vrem0 & 3) * 8;
  const int vdst0 = VOFF + (vsub0 * DV + (vrem0 >> 2)) * 80 + (vrem0 & 3) * 16;
  const int vsrc1 = vsrc0 + DV * 32, vdst1 = vdst0 + DV * 80;
  uint4 rk, rpe = make_uint4(0, 0, 0, 0), rv0, rv1 = make_uint4(0, 0, 0, 0);
#define ATT_GLOAD(i_) do { const int p0_ = (MODE == 0 || (i_) < 8) ? (i_) * 64 : win_pos0 + ((i_) - 8) * 64; \
    rk = *(const uint4*)(kp + (size_t)(p0_ + krow_l) * ldk + kpart * 8); \
    if (MLA && tid < 256) rpe = *(const uint4*)(kpe + (size_t)(p0_ + perow) * 32 + pepart * 8); \
    rv0 = *(const uint4*)(vp + (size_t)(p0_ >> 5) * (DV * 32) + vsrc0); \
    if (NVC == 2) rv1 = *(const uint4*)(vp + (size_t)(p0_ >> 5) * (DV * 32) + vsrc1); } while (0)
#define ATT_SSTORE(buf_) do { char* sb_ = smem + (buf_) * STAGE; \
    *(uint4*)(sb_ + krow_l * KSTR + kpart * 16) = rk; \
    if (MLA && tid < 256) *(uint4*)(sb_ + perow * KSTR + 128 + pepart * 16) = rpe; \
    *(uint4*)(sb_ + vdst0) = rv0; \
    if (NVC == 2) *(uint4*)(sb_ + vdst1) = rv1; } while (0)
  __syncthreads();
  ATT_GLOAD(0); ATT_SSTORE(0);
  __syncthreads();
#pragma unroll 1
  for (int i = 0; i < nst; ++i) {
    if (i + 1 < nst) ATT_GLOAD(i + 1);
    const char* sb = smem + (i & 1) * STAGE;
    const int pos0 = (MODE == 0 || i < 8) ? i * 64 : win_pos0 + (i - 8) * 64;
    const bool special = (MODE != 0) && (i >= 8);
    {
      int keyrow = 0, t0 = 0;
      bool use0 = true, use1 = true;
      if (MODE == 1 && special) { keyrow = (pos0 - 512) >> 6; use0 = use1 = (keyrow >= r0) && (keyrow < r0 + 8); }
      if (MODE == 2 && special) { t0 = pos0 - 512; use0 = (t0 >= tq0 - 128) && (t0 <= tq0 + 128); use1 = (t0 + 32 >= tq0 - 128) && (t0 + 32 <= tq0 + 128); }
      if (use0 || use1) {
        f32x16 S0, S1;
#pragma unroll
        for (int q = 0; q < 16; ++q) { S0[q] = 0.f; S1[q] = 0.f; }
        {
          bf16x8 kf[2][KS];
#pragma unroll
          for (int ks = 0; ks < KS; ++ks) {
            kf[0][ks] = *(const bf16x8*)(sb + kperm * KSTR + ks * 32 + hh * 16);
            kf[1][ks] = *(const bf16x8*)(sb + (32 + kperm) * KSTR + ks * 32 + hh * 16);
          }
          __builtin_amdgcn_sched_barrier(0);
#pragma unroll
          for (int ks = 0; ks < KS; ++ks) {
            S0 = MFMA(kf[0][ks], qf[ks], S0);
            S1 = MFMA(kf[1][ks], qf[ks], S1);
          }
        }
        bf16x8 vfa[2][MT];
#pragma unroll
        for (int s = 0; s < 2; ++s)
#pragma unroll
          for (int mt = 0; mt < MT; ++mt) vfa[s][mt] = *(const bf16x8*)(sb + VOFF + (mt * 32 + n) * 80 + s * 32 + hh * 16);
        __builtin_amdgcn_sched_barrier(0);
        float sv[32];
#pragma unroll
        for (int q = 0; q < 16; ++q) { sv[q] = S0[q]; sv[16 + q] = S1[q]; }
        if (MODE == 1 && special) {
#pragma unroll
          for (int q = 0; q < 32; ++q) {
            const int keycol = 32 * (q >> 4) + 16 * ((q >> 3) & 1) + 8 * hh + (q & 7);
            const bool valid = (unsigned)(keycol - c0) < 16u;
            int bi = (keyrow - r + 7) * 31 + (keycol - c + 15);
            bi = min(max(bi, 0), 464);
            const float bv = sbias[bi];
            sv[q] = valid ? sv[q] + bv : -1e30f;
          }
        }
        if (MODE == 2 && special) {
#pragma unroll
          for (int q = 0; q < 32; ++q) {
            const int d = t0 + 32 * (q >> 4) + 16 * ((q >> 3) & 1) + 8 * hh + (q & 7) - tq;
            sv[q] = (d >= -128 && d <= 128) ? sv[q] : -1e30f;
          }
        }
        float mx = sv[0];
#pragma unroll
        for (int q = 1; q < 32; ++q) mx = fmaxf(mx, sv[q]);
        mx = fmaxf(mx, __shfl_xor(mx, 32));
        const float mnew = fmaxf(m, mx);
        if (__any(mnew > m)) {
          const float alpha = ex2(m - mnew);
          l *= alpha;
#pragma unroll
          for (int mt = 0; mt < MT; ++mt)
#pragma unroll
            for (int q = 0; q < 16; ++q) O[mt][q] *= alpha;
        }
        m = mnew;
        float rs = 0.f;
#pragma unroll
        for (int q = 0; q < 32; ++q) { sv[q] = ex2(sv[q] - mnew); rs += sv[q]; }
        l += rs;
        bf16x8 pf[4];
#pragma unroll
        for (int s = 0; s < 4; ++s) {
          const u32 w0 = pk2(sv[8 * s + 0], sv[8 * s + 1]), w1 = pk2(sv[8 * s + 2], sv[8 * s + 3]);
          const u32 w2 = pk2(sv[8 * s + 4], sv[8 * s + 5]), w3 = pk2(sv[8 * s + 6], sv[8 * s + 7]);
          const uint4 pw = make_uint4(w0, w1, w2, w3);
          pf[s] = __builtin_bit_cast(bf16x8, pw);
        }
        bf16x8 vfb[2][MT];
#pragma unroll
        for (int s = 0; s < 2; ++s)
#pragma unroll
          for (int mt = 0; mt < MT; ++mt) vfb[s][mt] = *(const bf16x8*)(sb + VOFF + (DV + mt * 32 + n) * 80 + s * 32 + hh * 16);
        __builtin_amdgcn_sched_barrier(0);
#pragma unroll
        for (int s = 0; s < 2; ++s)
#pragma unroll
          for (int mt = 0; mt < MT; ++mt) O[mt] = MFMA(vfa[s][mt], pf[s], O[mt]);
#pragma unroll
        for (int s = 0; s < 2; ++s)
#pragma unroll
          for (int mt = 0; mt < MT; ++mt) O[mt] = MFMA(vfb[s][mt], pf[2 + s], O[mt]);
      }
    }
    if (i + 1 < nst) ATT_SSTORE((i + 1) & 1);
    __syncthreads();
  }
#undef ATT_GLOAD
#undef ATT_SSTORE
  const float inv = 1.f / (l + __shfl_xor(l, 32));
  if (EPI == 0) {
#pragma unroll
    for (int mt = 0; mt < MT; ++mt)
#pragma unroll
      for (int g = 0; g < 4; ++g) {
        uint2 o;
        o.x = pk2(O[mt][4 * g] * inv, O[mt][4 * g + 1] * inv);
        o.y = pk2(O[mt][4 * g + 2] * inv, O[mt][4 * g + 3] * inv);
        *(uint2*)(op + mt * 32 + 8 * g + 4 * hh) = o;
      }
  } else if (EPI == 1) {
#pragma unroll
    for (int mt = 0; mt < MT; ++mt)
#pragma unroll
      for (int q = 0; q < 8; ++q) park[(mt * 8 + q) * 64 + lane] = pk2(O[mt][2 * q] * inv, O[mt][2 * q + 1] * inv);
  } else {
    float ss = 0.f;
    const float li = lam * inv;
#pragma unroll
    for (int mt = 0; mt < MT; ++mt) {
#pragma unroll
      for (int q = 0; q < 8; ++q) {
        const u32 pw = park[(mt * 8 + q) * 64 + lane];
        const float v0 = bf2f((u16)(pw & 0xffff)) - li * O[mt][2 * q];
        const float v1 = bf2f((u16)(pw >> 16)) - li * O[mt][2 * q + 1];
        O[mt][2 * q] = v0; O[mt][2 * q + 1] = v1; ss += v0 * v0 + v1 * v1;
      }
      asm volatile("" ::: "memory");
    }
    ss += __shfl_xor(ss, 32);
    const float rn = rsqrtf(ss * (1.f / (MT * 32)) + 1e-5f) * 0.8f;
#pragma unroll
    for (int mt = 0; mt < MT; ++mt)
#pragma unroll
      for (int g = 0; g < 4; ++g) {
        const float4 sg = *(const float4*)(subln + mt * 32 + 8 * g + 4 * hh);
        uint2 o;
        o.x = pk2(O[mt][4 * g] * rn * sg.x, O[mt][4 * g + 1] * rn * sg.y);
        o.y = pk2(O[mt][4 * g + 2] * rn * sg.z, O[mt][4 * g + 3] * rn * sg.w);
        *(uint2*)(op + mt * 32 + 8 * g + 4 * hh) = o;
      }
  }
}

#define ATT_PIN(x) asm volatile("" : "+v"(x))
template <int KS, int MT, bool MLA, int EPI, int MODE = 0>
DI void attn_block_dense(char* smem, const u16* __restrict__ qp, const u16* __restrict__ kp, int ldk, const u16* __restrict__ kpe,
                         const u16* __restrict__ vp, u16* __restrict__ op, int nst, float m_init, float l_init,
                         float lam, const float* subln, u32* park,
                         int win_pos0 = 0, int r = 0, int r0 = 0, int c = 0, const float* sbias = nullptr, int tq0 = 0) {
  constexpr int DV = MT * 32;
  constexpr int KSTR = KS * 32 + 16;
  constexpr int VOFF = 64 * KSTR;
  constexpr int STAGE = VOFF + 2 * DV * 80;
  constexpr int NVC = (2 * DV * 4) / 512;
  constexpr int NA = 2 * KS, NB = 4 * MT;
  const int tid = ltid(), lane = tid & 63, n = lane & 31, hh = lane >> 5;
  const int kperm = (n & 16) + 8 * ((n >> 2) & 1) + 4 * ((n >> 3) & 1) + (n & 3);
  bf16x8 qf[KS];
#pragma unroll
  for (int ks = 0; ks < KS; ++ks) qf[ks] = *(const bf16x8*)(qp + ks * 16 + hh * 8);
  f32x16 O[MT];
  float m = m_init, l = l_init;
#pragma unroll
  for (int mt = 0; mt < MT; ++mt)
#pragma unroll
    for (int i = 0; i < 16; ++i) O[mt][i] = 0.f;
  const int krow_l = tid >> 3, kpart = tid & 7;
  const int perow = tid >> 2, pepart = tid & 3;
  const int vsub0 = tid / (DV * 4), vrem0 = tid - vsub0 * (DV * 4);
  const int vsrc0 = vsub0 * (DV * 32) + (vrem0 >> 2) * 32 + (vrem0 & 3) * 8;
  const int vdst0 = VOFF + (vsub0 * DV + (vrem0 >> 2)) * 80 + (vrem0 & 3) * 16;
  const int vsrc1 = vsrc0 + DV * 32, vdst1 = vdst0 + DV * 80;
  const int koff = kperm * KSTR + hh * 16;
  const int voff = VOFF + n * 80 + hh * 16;
  uint4 rk, rpe = make_uint4(0, 0, 0, 0), rv0, rv1 = make_uint4(0, 0, 0, 0);
#define ATD_GLOAD(i_) do { const int p0_ = (MODE == 0 || (i_) < 8) ? (i_) * 64 : win_pos0 + ((i_) - 8) * 64; \
    rk = *(const uint4*)(kp + (size_t)(p0_ + krow_l) * ldk + kpart * 8); \
    if (MLA && tid < 256) rpe = *(const uint4*)(kpe + (size_t)(p0_ + perow) * 32 + pepart * 8); \
    rv0 = *(const uint4*)(vp + (size_t)(p0_ >> 5) * (DV * 32) + vsrc0); \
    if (NVC == 2) rv1 = *(const uint4*)(vp + (size_t)(p0_ >> 5) * (DV * 32) + vsrc1); } while (0)
#define ATD_SSTORE(sb_) do { \
    *(uint4*)((sb_) + krow_l * KSTR + kpart * 16) = rk; \
    if (MLA && tid < 256) *(uint4*)((sb_) + perow * KSTR + 128 + pepart * 16) = rpe; \
    *(uint4*)((sb_) + vdst0) = rv0; \
    if (NVC == 2) *(uint4*)((sb_) + vdst1) = rv1; } while (0)
  __syncthreads();
  ATD_GLOAD(0); ATD_SSTORE(smem);
  __syncthreads();
  float pe[32];
  {
    if (1 < nst) ATD_GLOAD(1);
    const char* sb = smem;
    f32x16 S0, S1;
#pragma unroll
    for (int q = 0; q < 16; ++q) { S0[q] = 0.f; S1[q] = 0.f; }
#pragma unroll
    for (int ks = 0; ks < KS; ++ks) {
      const bf16x8 k0 = *(const bf16x8*)(sb + koff + ks * 32);
      const bf16x8 k1 = *(const bf16x8*)(sb + koff + 32 * KSTR + ks * 32);
      S0 = MFMA(k0, qf[ks], S0); S1 = MFMA(k1, qf[ks], S1);
    }
    float mx = S0[0];
#pragma unroll
    for (int q = 1; q < 16; ++q) mx = fmaxf(mx, S0[q]);
#pragma unroll
    for (int q = 0; q < 16; ++q) mx = fmaxf(mx, S1[q]);
    mx = fmaxf(mx, __shfl_xor(mx, 32));
    const float mnew = fmaxf(m, mx);
    l *= ex2(m - mnew);
    m = mnew;
#pragma unroll
    for (int q = 0; q < 16; ++q) { pe[q] = ex2(S0[q] - mnew); pe[16 + q] = ex2(S1[q] - mnew); }
    if (1 < nst) ATD_SSTORE(smem + STAGE);
    __syncthreads();
  }
  int cur = 1, prv = 0;
#pragma unroll 1
  for (int i = 1; i < nst; ++i) {
    if (i + 1 < nst) ATD_GLOAD(i + 1);
    const char* sb = smem + cur * STAGE;
    const char* sp = smem + prv * STAGE;
    f32x16 S0, S1;
    {
      const float nm = -m;
#pragma unroll
      for (int q = 0; q < 16; ++q) { S0[q] = nm; S1[q] = nm; }
    }
    f2_t racc = {0.f, 0.f};
    u32 pw[16];
    bf16x8 kfr[2];
    kfr[0] = *(const bf16x8*)(sb + koff);
    kfr[1] = *(const bf16x8*)(sb + koff + 32 * KSTR);
#pragma unroll
    for (int g = 0; g < NA; ++g) {
      const bf16x8 kf = kfr[g & 1];
      if (g + 2 < NA) kfr[g & 1] = *(const bf16x8*)(sb + koff + ((g + 2) & 1) * 32 * KSTR + ((g + 2) >> 1) * 32);
      if (g & 1) S1 = MFMA(kf, qf[g >> 1], S1); else S0 = MFMA(kf, qf[g >> 1], S0);
#pragma unroll
      for (int pp = (g * 16) / NA; pp < ((g + 1) * 16) / NA; ++pp) {
        const f2_t e2 = {pe[2 * pp], pe[2 * pp + 1]};
        racc += e2;
        pw[pp] = pk2(pe[2 * pp], pe[2 * pp + 1]);
        ATT_PIN(pw[pp]);
      }
      ATT_PIN(racc);
      __builtin_amdgcn_sched_barrier(0);
    }
    l += racc.x + racc.y;
    bf16x8 pf[4];
#pragma unroll
    for (int s = 0; s < 4; ++s) {
      const uint4 pq = make_uint4(pw[4 * s], pw[4 * s + 1], pw[4 * s + 2], pw[4 * s + 3]);
      pf[s] = __builtin_bit_cast(bf16x8, pq);
    }
    if (MODE != 0 && i >= 8) {
      const int pos0 = win_pos0 + (i - 8) * 64;
      if (MODE == 1) {
        const int keyrow = (pos0 - 512) >> 6;
        const bool rowok = (keyrow >= r0) && (keyrow < r0 + 8);
        const int c0 = min(max(c - 8, 0), 48);
#pragma unroll
        for (int q = 0; q < 32; ++q) {
          const int keycol = 32 * (q >> 4) + 16 * ((q >> 3) & 1) + 8 * hh + (q & 7);
          const bool valid = rowok && ((unsigned)(keycol - c0) < 16u);
          int bi = (keyrow - r + 7) * 31 + (keycol - c + 15);
          bi = min(max(bi, 0), 464);
          const float bv = sbias[bi];
          if (q < 16) S0[q & 15] = valid ? S0[q & 15] + bv : -1e30f; else S1[q & 15] = valid ? S1[q & 15] + bv : -1e30f;
        }
      } else {
        const int t0 = pos0 - 512, tq = tq0 + n;
#pragma unroll
        for (int q = 0; q < 32; ++q) {
          const int d = t0 + 32 * (q >> 4) + 16 * ((q >> 3) & 1) + 8 * hh + (q & 7) - tq;
          const bool valid = (d >= -128) && (d <= 128);
          if (q < 16) S0[q & 15] = valid ? S0[q & 15] : -1e30f; else S1[q & 15] = valid ? S1[q & 15] : -1e30f;
        }
      }
    }
    float mx = S0[0];
#pragma unroll
    for (int q = 1; q < 16; ++q) mx = fmaxf(mx, S0[q]);
#pragma unroll
    for (int q = 0; q < 16; ++q) mx = fmaxf(mx, S1[q]);
    mx = fmaxf(mx, __shfl_xor(mx, 32));
    const bool moved = __any(mx > 8.f);
    __builtin_amdgcn_sched_barrier(0);
#define ATD_PHASEB(SUB_) do { \
    bf16x8 vfr[2]; \
    vfr[0] = *(const bf16x8*)(sp + voff); \
    vfr[1] = *(const bf16x8*)(sp + voff + ((1 / MT) >> 1) * DV * 80 + (1 % MT) * 32 * 80 + ((1 / MT) & 1) * 32); \
    _Pragma("unroll") for (int j = 0; j < NB; ++j) { \
      const bf16x8 vf = vfr[j & 1]; \
      if (j + 2 < NB) { const int s2 = (j + 2) / MT, m2 = (j + 2) % MT; \
        vfr[j & 1] = *(const bf16x8*)(sp + voff + ((s2 >> 1) * DV + m2 * 32) * 80 + (s2 & 1) * 32); } \
      O[j % MT] = MFMA(vf, pf[j / MT], O[j % MT]); \
      _Pragma("unroll") for (int q = (j * 32) / NB; q < ((j + 1) * 32) / NB; ++q) { \
        pe[q] = ex2(q < 16 ? S0[q & 15] : S1[q & 15]); \
        ATT_PIN(pe[q]); } \
      __builtin_amdgcn_sched_barrier(0); } } while (0)
    float alpha = 1.f;
    if (moved) {
      const float dmx = fmaxf(mx, 0.f);
      alpha = ex2(-dmx);
      m += dmx;
      l *= alpha;
#pragma unroll
      for (int q = 0; q < 16; ++q) { S0[q] -= dmx; S1[q] -= dmx; }
    }
    ATD_PHASEB(+ 0.f);
#undef ATD_PHASEB
    if (moved) {
#pragma unroll
      for (int mt = 0; mt < MT; ++mt)
#pragma unroll
        for (int q = 0; q < 16; ++q) O[mt][q] *= alpha;
    }
    const int nxt = (cur == 2) ? 0 : cur + 1;
    if (i + 1 < nst) ATD_SSTORE(smem + nxt * STAGE);
    prv = cur; cur = nxt;
    __syncthreads();
  }
  {
    const char* sp = smem + prv * STAGE;
    float rs = 0.f;
#pragma unroll
    for (int q = 0; q < 32; ++q) rs += pe[q];
    l += rs;
#pragma unroll
    for (int s = 0; s < 4; ++s) {
      const uint4 pq = make_uint4(pk2(pe[8 * s], pe[8 * s + 1]), pk2(pe[8 * s + 2], pe[8 * s + 3]), pk2(pe[8 * s + 4], pe[8 * s + 5]), pk2(pe[8 * s + 6], pe[8 * s + 7]));
      const bf16x8 pfs = __builtin_bit_cast(bf16x8, pq);
#pragma unroll
      for (int mt = 0; mt < MT; ++mt) {
        const bf16x8 vf = *(const bf16x8*)(sp + voff + ((s >> 1) * DV + mt * 32) * 80 + (s & 1) * 32);
        O[mt] = MFMA(vf, pfs, O[mt]);
      }
    }
  }
#undef ATD_GLOAD
#undef ATD_SSTORE
  const float inv = 1.f / (l + __shfl_xor(l, 32));
  if (EPI == 0) {
#pragma unroll
    for (int mt = 0; mt < MT; ++mt)
#pragma unroll
      for (int g = 0; g < 4; ++g) {
        uint2 o;
        o.x = pk2(O[mt][4 * g] * inv, O[mt][4 * g + 1] * inv);
        o.y = pk2(O[mt][4 * g + 2] * inv, O[mt][4 * g + 3] * inv);
        *(uint2*)(op + mt * 32 + 8 * g + 4 * hh) = o;
      }
  } else if (EPI == 1) {
#pragma unroll
    for (int mt = 0; mt < MT; ++mt)
#pragma unroll
      for (int q = 0; q < 8; ++q) park[(mt * 8 + q) * 64 + lane] = pk2(O[mt][2 * q] * inv, O[mt][2 * q + 1] * inv);
  } else {
    float ss = 0.f;
    const float li = lam * inv;
#pragma unroll
    for (int mt = 0; mt < MT; ++mt) {
#pragma unroll
      for (int q = 0; q < 8; ++q) {
        const u32 pwd = park[(mt * 8 + q) * 64 + lane];
        const float v0 = bf2f((u16)(pwd & 0xffff)) - li * O[mt][2 * q];
        const float v1 = bf2f((u16)(pwd >> 16)) - li * O[mt][2 * q + 1];
        O[mt][2 * q] = v0; O[mt][2 * q + 1] = v1; ss += v0 * v0 + v1 * v1;
      }
      asm volatile("" ::: "memory");
    }
    ss += __shfl_xor(ss, 32);
    const float rn = rsqrtf(ss * (1.f / (MT * 32)) + 1e-5f) * 0.8f;
#pragma unroll
    for (int mt = 0; mt < MT; ++mt)
#pragma unroll
      for (int g = 0; g < 4; ++g) {
        const float4 sg = *(const float4*)(subln + mt * 32 + 8 * g + 4 * hh);
        uint2 o;
        o.x = pk2(O[mt][4 * g] * rn * sg.x, O[mt][4 * g + 1] * rn * sg.y);
        o.y = pk2(O[mt][4 * g + 2] * rn * sg.z, O[mt][4 * g + 3] * rn * sg.w);
        *(uint2*)(op + mt * 32 + 8 * g + 4 * hh) = o;
      }
  }
}

template <int LAYER>
DI void attn_phase(const Params& p, char* smem) {
  constexpr int NH = (LAYER == 0) ? 8 : 16;
  constexpr int nlat = 8 * NH * 16, nctx = 32 * NH;
  const int w = ltid() >> 6, lane = ltid() & 63, n = lane & 31, hh = lane >> 5;
  const u16* Q = (const u16*)(p.ws + WS_R + R_Q);
  const u16* Kb = (const u16*)(p.ws + WS_R + R_K);
  const u16* Vt = (const u16*)(p.ws + WS_R + R_VT);
  const u16* KPE = (const u16*)(p.ws + WS_R + R_KPE);
  u16* Ob = (u16*)(p.ws + WS_H);
  float lam = 0.f;
  if (LAYER == 0) {
    const float* lp = p.in[19];
    float a = lp[lane] * lp[64 + lane], b = lp[128 + lane] * lp[192 + lane];
#pragma unroll
    for (int o = 32; o > 0; o >>= 1) { a += __shfl_xor(a, o); b += __shfl_xor(b, o); }
    lam = expf(a) - expf(b) + 0.2f;
  }
  float* sbias = (float*)(smem + ATT_PARK);
  u32* park = (u32*)(smem + ATT_PARK) + w * 2048;
#pragma unroll 1
  for (int item0 = blockIdx.x; item0 < nlat + nctx; item0 += gridDim.x) {
    const bool lat = item0 < nlat;
    int item = item0;
    if (lat && gridDim.x == 256) {
      const int xcd = blockIdx.x & 7, slot = blockIdx.x >> 3;
      item = (((item0 >> 8) * 16 + xcd * 2 + (slot >> 4)) << 4) + (slot & 15);
    }
    int b, h, qb;
    if (lat) { qb = item & 15; h = (item >> 4) % NH; b = (item >> 4) / NH; }
    else { const int it2 = item - nlat; qb = 0; h = it2 % NH; b = it2 / NH; }
    const int q0 = qb * 256;
    const int tq0 = q0 + w * 32;
    const int row = lat ? NCTX + b * 4096 + tq0 + n : b * 256 + tq0 + n;
    const int krow0 = lat ? NCTX + b * LATS : b * 256;
    const int nst_dense = lat ? 72 : 4;
    if (LAYER == 0) {
      const u16* vp = Vt + (lat ? (size_t)NCTX * 1024 : 0) + (size_t)((b * 8 + h) * (lat ? 144 : 8)) * (128 * 32);
      attn_block_dense<4, 4, false, 1>(smem, Q + (size_t)row * 1024 + h * 128, Kb + (size_t)krow0 * 1024 + h * 128, 1024, nullptr, vp,
                                       Ob + (size_t)row * 1024 + h * 128, nst_dense, -1e30f, 0.f, lam, p.in[20], park);
      attn_block_dense<4, 4, false, 2>(smem, Q + (size_t)row * 1024 + h * 128 + 64, Kb + (size_t)krow0 * 1024 + h * 128 + 64, 1024, nullptr, vp,
                                       Ob + (size_t)row * 1024 + h * 128, nst_dense, -1e30f, 0.f, lam, p.in[20], park);
    } else if (LAYER == 1) {
      const u16* vp = Vt + (lat ? (size_t)NCTX * 1024 : 0) + (size_t)((b * 16 + h) * (lat ? 144 : 8)) * (64 * 32);
      if (lat) {
        __syncthreads();
        for (int i = ltid(); i < 465; i += 512) sbias[i] = p.in[23][h * 465 + i] * LOG2E;
        const int r = qb * 4 + (w >> 1), c = (w & 1) * 32 + n;
        const int r0 = min(max(r - 4, 0), 56);
        const int gr_lo = min(max(qb * 4 - 4, 0), 56), gr_hi = min(max(qb * 4 + 3 - 4, 0), 56) + 8;
        attn_block_dense<4, 2, false, 0, 1>(smem, Q + (size_t)row * 1024 + h * 64, Kb + (size_t)krow0 * 1024 + h * 64, 1024, nullptr, vp,
                                            Ob + (size_t)row * 1024 + h * 64, 8 + gr_hi - gr_lo, -1e30f, 0.f, 0.f, nullptr, nullptr,
                                            512 + gr_lo * 64, r, r0, c, sbias, tq0);
      } else {
        attn_block_dense<4, 2, false, 0>(smem, Q + (size_t)row * 1024 + h * 64, Kb + (size_t)krow0 * 1024 + h * 64, 1024, nullptr, vp,
                                         Ob + (size_t)row * 1024 + h * 64, 4, -1e30f, 0.f, 0.f, nullptr, nullptr);
      }
    } else if (LAYER == 2) {
      const u16* vp = Vt + (lat ? (size_t)NCTX * 1024 : 0) + (size_t)((b * 16 + h) * (lat ? 144 : 8)) * (64 * 32);
      attn_block_dense<6, 2, true, 0>(smem, Q + (size_t)row * 1536 + h * 96, Kb + (size_t)krow0 * 1024 + h * 64, 1024, KPE + (size_t)krow0 * 32, vp,
                                      Ob + (size_t)row * 1024 + h * 64, nst_dense, -1e30f, 0.f, 0.f, nullptr, nullptr);
    } else {
      const int hk = h >> 2;
      const u16* vp = Vt + (lat ? (size_t)NCTX * 256 : 0) + (size_t)((b * 4 + hk) * (lat ? 144 : 8)) * (64 * 32);
      const float sk = p.in[32][h] * LOG2E;
      const float li = hh == 0 ? 1.f : 0.f;
      if (lat) {
        const int j_lo = q0 == 0 ? 2 : 0;
        const int j_hi = min(10, (4096 + 128 - q0) >> 6);
        attn_block_dense<4, 2, false, 0, 2>(smem, Q + (size_t)row * 1024 + h * 64, Kb + (size_t)krow0 * 256 + hk * 64, 256, nullptr, vp,
                                            Ob + (size_t)row * 1024 + h * 64, 8 + j_hi - j_lo, sk, li, 0.f, nullptr, nullptr,
                                            512 + q0 - 128 + 64 * j_lo, 0, 0, 0, nullptr, tq0);
      } else {
        attn_block_dense<4, 2, false, 0>(smem, Q + (size_t)row * 1024 + h * 64, Kb + (size_t)krow0 * 256 + hk * 64, 256, nullptr, vp,
                                         Ob + (size_t)row * 1024 + h * 64, 4, sk, li, 0.f, nullptr, nullptr);
      }
    }
  }
}

#define XB_TMO      128
#define XB_XCNT(j)  (256  + 64 * (j))
#define XB_XSUB(j)  (1280 + 64 * (j))
#define XB_XGEN(j)  (2304 + 64 * (j))
#define XB_TOP      3328
#define XB_TOPGEN   3392
#define XCD_BAR_WORDS 3456
#define XB_SPIN_CAP (1u << 18)
DI unsigned xb_ld(unsigned* p) { return __hip_atomic_load(p, __ATOMIC_RELAXED, __HIP_MEMORY_SCOPE_AGENT); }
DI unsigned xb_add(unsigned* p, unsigned v) { return __hip_atomic_fetch_add(p, v, __ATOMIC_RELAXED, __HIP_MEMORY_SCOPE_AGENT); }
DI unsigned xb_xcc_id() { return (unsigned)__builtin_amdgcn_s_getreg((3 << 11) | 20) & 0xFu; }
#define XB_SPIN(cond, bar) do { unsigned _sp = 0; while (cond) { __builtin_amdgcn_s_sleep(1); \
    if ((++_sp & 255u) == 0u) { if (xb_ld(&(bar)[XB_TMO])) break; if (_sp > XB_SPIN_CAP) { atomicAdd(&(bar)[XB_TMO], 1u); break; } } } } while (0)
struct XcdBarrier { unsigned* bar; unsigned x; volatile PG8_LAS unsigned* st; };
DI XcdBarrier xcd_barrier_post(unsigned* bar, volatile PG8_LAS unsigned* st) {
  XcdBarrier b; b.bar = bar; b.x = xb_xcc_id(); b.st = st;
  if (threadIdx.x == 0) (void)xb_add(&bar[XB_XCNT(b.x)], 1u);
  return b;
}
DI void xcd_barrier_complete(unsigned* bar, unsigned x, unsigned& nloc, unsigned& nx) {
  const unsigned G = gridDim.x * gridDim.y * gridDim.z;
  unsigned sum, cnt, mine, sp = 0u;
  for (;;) {
    sum = 0u; cnt = 0u; mine = 0u;
#pragma unroll
    for (unsigned j = 0; j < 16; ++j) { const unsigned c = xb_ld(&bar[XB_XCNT(j)]); sum += c; cnt += (c > 0u) ? 1u : 0u; mine = (j == x) ? c : mine; }
    if (sum == G) break;
    __builtin_amdgcn_s_sleep(1);
    if ((++sp & 255u) == 0u) { if (xb_ld(&bar[XB_TMO])) break; if (sp > XB_SPIN_CAP) { atomicAdd(&bar[XB_TMO], 1u); break; } }
  }
  nloc = mine > 0u ? mine : 1u; nx = cnt > 0u ? cnt : 1u;
}
DI void xcd_barrier(const XcdBarrier& b) {
  asm volatile("s_waitcnt vmcnt(0)" ::: "memory");
  __syncthreads();
  if (threadIdx.x == 0) {
    unsigned* bar = b.bar;
    __builtin_amdgcn_s_waitcnt(0);
    unsigned nloc = b.st[0], nx = b.st[1];
    if (nloc == 0u) { xcd_barrier_complete(bar, b.x, nloc, nx); b.st[0] = nloc; b.st[1] = nx; }
    const unsigned old = xb_add(&bar[XB_XSUB(b.x)], 1u);
    const unsigned gen = old / nloc;
    if (old + 1u == (gen + 1u) * nloc) {
      __builtin_amdgcn_fence(__ATOMIC_RELEASE, "agent");
      asm volatile("s_waitcnt vmcnt(0)" ::: "memory");
      const unsigned og = xb_add(&bar[XB_TOP], 1u);
      const unsigned tg = og / nx;
      if (og + 1u == (tg + 1u) * nx) xb_add(&bar[XB_TOPGEN], 1u);
      else XB_SPIN(xb_ld(&bar[XB_TOPGEN]) == tg, bar);
      __builtin_amdgcn_fence(__ATOMIC_ACQUIRE, "agent");
      xb_add(&bar[XB_XGEN(b.x)], 1u);
      asm volatile("s_waitcnt vmcnt(0)" ::: "memory");
    } else {
      XB_SPIN(xb_ld(&bar[XB_XGEN(b.x)]) == gen, bar);
      __builtin_amdgcn_fence(__ATOMIC_ACQUIRE, "agent");
      asm volatile("s_waitcnt vmcnt(0)" ::: "memory");
    }
  }
  __syncthreads();
}

DI void setup_gemm(const Params& p, int layer, int sub, Sched2& S, Epi2& E) {
  u16* wt = (u16*)(p.ws + WS_W);
  u16* H = (u16*)(p.ws + WS_H);
  char* R = p.ws + WS_R;
  GJ j = gj_base(p);
  const u16* act = H; const u16* w = wt; int M = NTOK, K = 1024, N0 = 1024, NV = 0;
  if (sub == 0) {
    if (layer == 0) {
      j.n_k0 = 1024;
      j.oq = (u16*)(R + R_Q); j.ldq = 1024; j.qrope = 1; j.qscale = 0.125f * LOG2E;
      j.ok = (u16*)(R + R_K); j.ldk = 1024; j.krope = 1; j.kst = p.out + O_K0; j.ldkst = 1024;
      j.ovt = (u16*)(R + R_VT); j.HV = 8; j.dvshift = 7; j.vst = p.out + O_V0; j.ldvst = 1024;
      w = wt + W_L0QKV; N0 = 2048; NV = 1024;
    } else if (layer == 1) {
      j.n_k0 = 1024;
      j.oq = (u16*)(R + R_Q); j.ldq = 1024; j.qrope = 0; j.qscale = 0.125f * LOG2E;
      j.ok = (u16*)(R + R_K); j.ldk = 1024; j.krope = 0; j.kst = p.out + O_K1; j.ldkst = 1024;
      j.ovt = (u16*)(R + R_VT); j.HV = 16; j.dvshift = 6; j.vst = p.out + O_V1; j.ldvst = 1024;
      w = wt + W_L1QKV; N0 = 2048; NV = 1024;
    } else if (layer == 2) {
      j.nvalid = 800; j.oq = (u16*)R; j.ldq = 800;
      w = wt + W_L2A; N0 = 1024; NV = 0;
    } else {
      j.n_k0 = 1024;
      j.oq = (u16*)(R + R_Q); j.ldq = 1024; j.qrope = 1; j.qscale = 0.125f * LOG2E;
      j.ok = (u16*)(R + R_K); j.ldk = 256; j.krope = 1; j.kst = p.out + O_K3; j.ldkst = 256;
      j.ovt = (u16*)(R + R_VT); j.HV = 4; j.dvshift = 6; j.vst = p.out + O_V3; j.ldvst = 256;
      w = wt + W_L3QKV; N0 = 1280; NV = 256;
    }
  } else if (sub == 2) {
    j.oq = (u16*)(R + R_Q); j.ldq = 1536; j.qrope = 2; j.qscale = 0.10206207261596577f * LOG2E;
    w = wt + W_L2UQ; K = 512; N0 = 1536;
  } else if (sub == 3) {
    j.n_k0 = 0; j.kspace = 1;
    j.ok = (u16*)(R + R_K); j.ldk = 1024; j.krope = 0;
    j.ovt = (u16*)(R + R_VT); j.HV = 16; j.dvshift = 6;
    act = H + (size_t)NTOK * 512; w = wt + W_L2UKV; M = NKROW; K = 256; N0 = 1024; NV = 1024;
  } else if (sub == 5) {
    const size_t wo = layer == 0 ? W_L0O : layer == 1 ? W_L1O : layer == 2 ? W_L2O : W_L3O;
    j.oq = (u16*)(R + R_Q); j.ldq = 1024; j.simple = 1;
    w = wt + wo;
  } else if (sub == 7) {
    j.oq = (u16*)R; j.ldq = 4096; j.relu2 = 1; j.simple = 1;
    w = wt + W_MLP1 + (size_t)layer * 4 * Mi; N0 = 4096;
  } else {
    j.oq = H; j.ldq = 1024; j.simple = 1;
    act = (const u16*)R; w = wt + W_MLP2 + (size_t)layer * 4 * Mi; K = 4096;
  }
  S.act = (const char*)act; S.w = (const char*)w; S.K = K; S.tstep = (size_t)256 * K * 2; S.w1off = (size_t)N0 * K * 2;
  S.nM0 = M / 256; S.nN0 = N0 / 256; S.nM1 = NV / 256; S.rev = (sub == 8) ? 1 : 0; S.n0 = S.nM0 * S.nN0; S.n1 = S.nM1 * S.nM0; S.G = gridDim.x; S.c = blockIdx.x;
  E.j = j;
}

__global__ void __launch_bounds__(512, 2) mega(Params p) {
  cg::grid_group grid = cg::this_grid();
  __shared__ __attribute__((aligned(16))) char smem[155648];
  char* R = p.ws + WS_R;
  u16* H = (u16*)(p.ws + WS_H);
  const float* mods = (const float*)(p.ws + WS_MODS);
  __shared__ uint4 xb_words;
  if (threadIdx.x == 0) xb_words = make_uint4(0u, 0u, 0u, 0u);
  __syncthreads();
  const XcdBarrier xb = xcd_barrier_post((unsigned*)(p.ws + WS_BAR), (volatile PG8_LAS unsigned*)&xb_words);
  prepass(p, smem);
  xcd_barrier(xb);
  if (p.ws == nullptr) grid.sync();
  h0_pass(p);
  xcd_barrier(xb);
#pragma unroll 1
  for (int step = 0; step < 40; ++step) {
    const int layer = step / 10, sub = step - layer * 10;
    if (sub == 3 || (layer != 2 && (sub == 1 || sub == 2))) continue;
    if (sub == 0 && layer != 2) {
      const float* ck = layer == 0 ? p.in[2] : layer == 1 ? p.in[4] : p.in[8];
      const float* cv = layer == 0 ? p.in[3] : layer == 1 ? p.in[5] : p.in[9];
      cache_convert(p, ck, cv, (u16*)(R + R_K), (u16*)(R + R_VT), layer == 3 ? 256 : 1024, layer == 0 ? 8 : layer == 1 ? 16 : 4, layer == 0 ? 128 : 64);
    }
    if (sub == 0 || sub == 2 || sub == 3 || sub == 5 || sub == 7 || sub == 8) {
      const int njobs = (sub == 2) ? 2 : 1;
#pragma unroll 1
      for (int jb = 0; jb < njobs; ++jb) {
        Sched2 S; Epi2 E;
        setup_gemm(p, layer, sub + jb, S, E);
        gemm_phase((PG8_LAS unsigned char*)smem, S, E);
      }
    } else if (sub == 1) {
      mla_norm_pass(p);
    } else if (sub == 4) {
      if (layer == 0) attn_phase<0>(p, smem);
      else if (layer == 1) attn_phase<1>(p, smem);
      else if (layer == 2) attn_phase<2>(p, smem);
      else attn_phase<3>(p, smem);
    } else {
      const float* ml = mods + (size_t)layer * 9 * 6144;
      if (sub == 6) {
        const float* xc = layer == 0 ? p.in[0] : p.out;
        const float* xl = layer == 0 ? p.in[1] : p.out + (size_t)NCTX * DM;
        ln_pass(p, (const u16*)(R + R_Q), ml + 2 * 1024, p.in[14] + (size_t)(layer * 2) * 1024, p.in[15] + (size_t)(layer * 2) * 1024, ml + 3 * 1024);
      } else {
        const float* mn = layer < 3 ? mods + (size_t)(layer + 1) * 9 * 6144 : nullptr;
        ln_pass(p, H, ml + 5 * 1024, p.in[14] + (size_t)(layer * 2 + 1) * 1024, p.in[15] + (size_t)(layer * 2 + 1) * 1024, mn);
      }
    }
    xcd_barrier(xb);
  }
}

extern "C" void kernel_launch(void* const* d_in, const int* in_sizes, int n_in, void* d_out, int out_size, void* d_ws,
                              size_t ws_size, hipStream_t stream) {
  static int grid_blocks = 0;
  if (!grid_blocks) {
    int dev = 0, cus = 0, per_cu = 0;
    hipGetDevice(&dev);
    hipDeviceGetAttribute(&cus, hipDeviceAttributeMultiprocessorCount, dev);
    hipOccupancyMaxActiveBlocksPerMultiprocessor(&per_cu, mega, 512, 0);
    if (per_cu > 1) per_cu = 1;
    grid_blocks = cus * per_cu;
  }
  if (ws_size < WS_TOTAL) fprintf(stderr, "workspace too small: %zu < %zu\n", ws_size, (size_t)WS_TOTAL);
  Params p{};
  for (int i = 0; i < 34; ++i) p.in[i] = (const float*)d_in[i];
  p.out = (float*)d_out;
  p.ws = (char*)d_ws;
  (void)hipMemsetAsync((char*)d_ws + WS_BAR, 0, XCD_BAR_WORDS * 4, stream);
  void* args[] = {&p};
  hipError_t e = hipLaunchCooperativeKernel((void*)mega, dim3(grid_blocks), dim3(512), args, 0, stream);
  if (e != hipSuccess) fprintf(stderr, "cooperative launch failed: %s (grid %d)\n", hipGetErrorString(e), grid_blocks);
}
```
